# Optimizing an MI355X kernel written in HIP

```python
import math
import jax, jax.numpy as jnp
from jax import lax
import numpy as np

D_MODEL = 1024
BATCH = 16
SEQ = 2048
DEPTH = 2

N_DIFF_HEADS = 4
DIFF_QK_DIM = 64
DIFF_V_DIM = 2 * DIFF_QK_DIM
ATTN_WIDTH = N_DIFF_HEADS * DIFF_V_DIM
Q_BLOCK = 128

SSD_HEAD_DIM = 64
SSD_WIDTH = D_MODEL // 2
SSD_HEADS = SSD_WIDTH // SSD_HEAD_DIM
SSD_GROUPS = 2
SSD_HEADS_PER_GROUP = SSD_HEADS // SSD_GROUPS
SSD_STATE = 64
SSD_CONV = 5
SSD_CHUNK = 128
SSD_CONV_CH = SSD_WIDTH + 2 * SSD_GROUPS * SSD_STATE
DT_MIN = 1e-3
DT_MAX = 1e-1

Q_COLS = N_DIFF_HEADS * 2 * DIFF_QK_DIM
K_COLS = Q_COLS
V_COLS = ATTN_WIDTH
Z_COLS = SSD_WIDTH
DT_COLS = 2 * SSD_HEADS
IN_COLS = Q_COLS + K_COLS + V_COLS + Z_COLS + SSD_CONV_CH + DT_COLS
SPLIT_POINTS = [Q_COLS, Q_COLS + K_COLS, Q_COLS + K_COLS + V_COLS,
                Q_COLS + K_COLS + V_COLS + Z_COLS,
                Q_COLS + K_COLS + V_COLS + Z_COLS + SSD_CONV_CH]
MIX_WIDTH = ATTN_WIDTH + SSD_WIDTH

FOURIER_GROUPS = 4
FOURIER_GROUP_DIM = D_MODEL // FOURIER_GROUPS

MOE_GROUPS = 4
MOE_EXPERTS_PER_GROUP = 8
MOE_EXPERTS = MOE_GROUPS * MOE_EXPERTS_PER_GROUP
MOE_TOP_K = 2
MOE_HIDDEN = 256
MOE_BLOCK = 128

RMS_EPS = 1e-6
N_EVEN = (DEPTH + 1) // 2
N_ODD = DEPTH // 2

kernel_name = 'hybrid_diffattn_ssd_fnet_hmoe_encoder'


def rmsnorm(x, w):
    xf = x.astype(jnp.float32)
    y = xf * lax.rsqrt(jnp.mean(xf * xf, axis=-1, keepdims=True) + RMS_EPS)
    return (y * w.astype(jnp.float32)).astype(x.dtype)


def alibi_slopes(n):
    return jnp.asarray(np.array([2.0 ** (-8.0 * (h + 1) / n) for h in range(n)], dtype=np.float32))


def diff_attention(q, k, v, lam, subln_w, lambda_init):
    b, s = q.shape[0], q.shape[1]
    nb = s // Q_BLOCK
    scale = DIFF_QK_DIM ** -0.5
    slopes = alibi_slopes(N_DIFF_HEADS)
    kf = k.astype(jnp.float32)
    vf = v.astype(jnp.float32)
    key_pos = jnp.arange(s, dtype=jnp.float32)
    qb = q.astype(jnp.float32).reshape(b, nb, Q_BLOCK, N_DIFF_HEADS, 2, DIFF_QK_DIM).transpose(1, 0, 2, 3, 4, 5)
    starts = jnp.arange(nb, dtype=jnp.int32) * Q_BLOCK

    def block(args):
        qi, start = args
        scores = jnp.einsum('bqhcd,bkhcd->bhcqk', qi, kf) * scale
        q_pos = (start + jnp.arange(Q_BLOCK, dtype=jnp.int32)).astype(jnp.float32)
        dist = jnp.abs(q_pos[:, None] - key_pos[None, :])
        scores = scores - slopes[None, :, None, None, None] * dist
        probs = jax.nn.softmax(scores, axis=-1)
        weights = probs[:, :, 0] - lam * probs[:, :, 1]
        return jnp.einsum('bhqk,bkhd->bqhd', weights, vf)

    o = lax.map(block, (qb, starts))
    o = o.transpose(1, 0, 2, 3, 4).reshape(b, s, N_DIFF_HEADS, DIFF_V_DIM)
    o = rmsnorm(o, subln_w) * (1.0 - lambda_init)
    return o.reshape(b, s, ATTN_WIDTH)


def segsum(a):
    t = a.shape[-1]
    rep = jnp.broadcast_to(a[..., :, None], a.shape + (t,))
    strict = jnp.tril(jnp.ones((t, t), dtype=bool), -1)
    rep = jnp.where(strict, rep, 0.0)
    ss = jnp.cumsum(rep, axis=-2)
    return jnp.where(jnp.tril(jnp.ones((t, t), dtype=bool)), ss, -jnp.inf)


def ssd_scan(xdt, dta, bh, ch):
    b, s, h, p = xdt.shape
    n = bh.shape[-1]
    c = s // SSD_CHUNK
    xc = xdt.reshape(b, c, SSD_CHUNK, h, p)
    bc = bh.reshape(b, c, SSD_CHUNK, h, n)
    cc = ch.reshape(b, c, SSD_CHUNK, h, n)
    ac = dta.reshape(b, c, SSD_CHUNK, h).transpose(0, 3, 1, 2)
    a_cs = jnp.cumsum(ac, axis=-1)
    l_mat = jnp.exp(segsum(ac))
    y_diag = jnp.einsum('bclhn,bcshn,bhcls,bcshp->bclhp', cc, bc, l_mat, xc)
    decay_states = jnp.exp(a_cs[..., -1:] - a_cs)
    states = jnp.einsum('bclhn,bhcl,bclhp->bchpn', bc, decay_states, xc)
    states = jnp.concatenate([jnp.zeros_like(states[:, :1]), states], axis=1)
    chunk_decay = jnp.exp(segsum(jnp.pad(a_cs[..., -1], ((0, 0), (0, 0), (1, 0)))))
    states = jnp.einsum('bhzc,bchpn->bzhpn', chunk_decay, states)[:, :-1]
    y_off = jnp.einsum('bclhn,bchpn,bhcl->bclhp', cc, states, jnp.exp(a_cs))
    return (y_diag + y_off).reshape(b, s, h, p)


def centred_dwconv(x, w, bias):
    k = w.shape[0]
    y = lax.conv_general_dilated(x, w[:, None, :], window_strides=(1,), padding=[(k // 2, k // 2)],
                                 dimension_numbers=('NWC', 'WIO', 'NWC'), feature_group_count=x.shape[-1])
    return y + bias


def ssd_mixer(z, xbc, dt_raw, conv_w, conv_b, dt_bias, a_log, d_skip, norm_w):
    b, s, _ = xbc.shape
    f32 = jnp.float32
    xbc = jax.nn.silu(centred_dwconv(xbc.astype(f32), conv_w.astype(f32), conv_b.astype(f32)))
    xs = xbc[..., :SSD_WIDTH].reshape(b, s, SSD_HEADS, SSD_HEAD_DIM)
    bm = xbc[..., SSD_WIDTH:SSD_WIDTH + SSD_GROUPS * SSD_STATE].reshape(b, s, SSD_GROUPS, SSD_STATE)
    cm = xbc[..., SSD_WIDTH + SSD_GROUPS * SSD_STATE:].reshape(b, s, SSD_GROUPS, SSD_STATE)
    bh = jnp.repeat(bm, SSD_HEADS_PER_GROUP, axis=2)
    ch = jnp.repeat(cm, SSD_HEADS_PER_GROUP, axis=2)
    dt = jax.nn.softplus(dt_raw.astype(f32).reshape(b, s, 2, SSD_HEADS) + dt_bias.astype(f32))
    a = -jnp.exp(a_log.astype(f32))
    dt_f, dt_b = dt[:, :, 0], dt[:, :, 1]
    y_f = ssd_scan(xs * dt_f[..., None], dt_f * a[0], bh, ch)
    flip = lambda t: jnp.flip(t, axis=1)
    y_b = flip(ssd_scan(flip(xs * dt_b[..., None]), flip(dt_b * a[1]), flip(bh), flip(ch)))
    y = y_f + y_b + d_skip.astype(f32)[:, None] * xs
    y = y.reshape(b, s, SSD_WIDTH) * jax.nn.silu(z.astype(f32))
    return rmsnorm(y, norm_w)


def diff_ssd_mixer(h, w_in, q_norm, k_norm, lq1, lk1, lq2, lk2, subln, conv_w, conv_b,
                   dt_bias, a_log, d_skip, ssd_norm, w_out, lambda_init):
    b, s, _ = h.shape
    f32 = jnp.float32
    proj = h @ w_in
    q, k, v, z, xbc, dt_raw = jnp.split(proj, SPLIT_POINTS, axis=-1)
    q = rmsnorm(q.reshape(b, s, N_DIFF_HEADS, 2, DIFF_QK_DIM), q_norm)
    k = rmsnorm(k.reshape(b, s, N_DIFF_HEADS, 2, DIFF_QK_DIM), k_norm)
    v = v.reshape(b, s, N_DIFF_HEADS, DIFF_V_DIM)
    lam = (jnp.exp(jnp.sum(lq1.astype(f32) * lk1.astype(f32)))
           - jnp.exp(jnp.sum(lq2.astype(f32) * lk2.astype(f32))) + lambda_init)
    attn = diff_attention(q, k, v, lam, subln, lambda_init)
    ssd = ssd_mixer(z, xbc, dt_raw, conv_w, conv_b, dt_bias, a_log, d_skip, ssd_norm)
    mixed = jnp.concatenate([attn.astype(h.dtype), ssd.astype(h.dtype)], axis=-1)
    return mixed @ w_out


def fourier_mixer(h, w_f):
    b, s, d = h.shape
    hg = h.astype(jnp.float32).reshape(b, s, FOURIER_GROUPS, FOURIER_GROUP_DIM)
    f = jnp.fft.fft2(hg, axes=(1, 3), norm='ortho').real
    return f.reshape(b, s, d).astype(h.dtype) @ w_f


def expert_dispatch(xf, expert_idx, gates, w1, w3, w2):
    t, d = xf.shape
    n_assign = t * MOE_TOP_K
    n_blocks = -(-n_assign // MOE_BLOCK) + MOE_EXPERTS
    p_rows = n_blocks * MOE_BLOCK
    flat_e = expert_idx.reshape(n_assign)
    flat_tok = jnp.repeat(jnp.arange(t, dtype=jnp.int32), MOE_TOP_K)
    flat_g = gates.reshape(n_assign)
    order = jnp.argsort(flat_e)
    se, st, sg = flat_e[order], flat_tok[order], flat_g[order]
    counts = jnp.bincount(flat_e, length=MOE_EXPERTS)
    padded = (counts + MOE_BLOCK - 1) // MOE_BLOCK * MOE_BLOCK
    start = jnp.cumsum(counts) - counts
    pad_end = jnp.cumsum(padded)
    pad_start = pad_end - padded
    dest = pad_start[se] + (jnp.arange(n_assign, dtype=jnp.int32) - start[se])
    tok_buf = jnp.full((p_rows,), t, dtype=jnp.int32).at[dest].set(st)
    block_start = jnp.arange(n_blocks, dtype=jnp.int32) * MOE_BLOCK
    block_expert = jnp.minimum(jnp.sum(block_start[:, None] >= pad_end[None, :], axis=1), MOE_EXPERTS - 1)
    x_pad = jnp.concatenate([xf, jnp.zeros((1, d), xf.dtype)], axis=0)
    xb = x_pad[tok_buf].reshape(n_blocks, MOE_BLOCK, d)

    def run_block(args):
        xblk, e = args
        hid = jax.nn.silu(xblk @ w1[e]) * (xblk @ w3[e])
        return hid @ w2[e]

    yb = lax.map(run_block, (xb, block_expert)).reshape(p_rows, d)
    y_assign = yb[dest] * sg[:, None].astype(yb.dtype)
    return jnp.zeros((t, d), yb.dtype).at[st].add(y_assign)


def hier_moe(h, rg_w, rg_b, re_w, re_b, w1, w3, w2):
    b, s, d = h.shape
    t = b * s
    f32 = jnp.float32
    xf = h.reshape(t, d)
    x32 = xf.astype(f32)
    g_prob = jax.nn.softmax(x32 @ rg_w.astype(f32) + rg_b.astype(f32), axis=-1)
    g_p, g_idx = lax.top_k(g_prob, 1)
    g_p, g_idx = g_p[:, 0], g_idx[:, 0]
    e_logits = jnp.einsum('td,dge->tge', x32, re_w.astype(f32)) + re_b.astype(f32)
    e_sel = e_logits[jnp.arange(t), g_idx]
    e_prob = jax.nn.softmax(e_sel, axis=-1)
    e_p, e_local = lax.top_k(e_prob, MOE_TOP_K)
    e_p = e_p / jnp.sum(e_p, axis=-1, keepdims=True)
    gates = g_p[:, None] * e_p
    expert_idx = g_idx[:, None] * MOE_EXPERTS_PER_GROUP + e_local
    y = expert_dispatch(xf, expert_idx, gates, w1, w3, w2)
    return y.reshape(b, s, d).astype(h.dtype)


def setup_inputs(seed: int = 0) -> dict:
    key = jax.random.key(seed)
    ks = jax.random.split(key, 26)
    f32 = jnp.float32
    nrm = lambda k, shape, scale: jax.random.normal(k, shape, f32) * scale
    gain = lambda k, shape: 1.0 + 0.02 * jax.random.normal(k, shape, f32)
    u = jax.random.uniform(ks[13], (N_EVEN, 2, SSD_HEADS), f32)
    dt0 = jnp.exp(u * (math.log(DT_MAX) - math.log(DT_MIN)) + math.log(DT_MIN))
    dt_bias = dt0 + jnp.log(-jnp.expm1(-dt0))
    a_log = jnp.log(jax.random.uniform(ks[14], (N_EVEN, 2, SSD_HEADS), f32, minval=1.0, maxval=16.0))
    return {
        'x': nrm(ks[0], (BATCH, SEQ, D_MODEL), 1.0),
        'norm_mix': gain(ks[1], (DEPTH, D_MODEL)),
        'norm_ffn': gain(ks[2], (DEPTH, D_MODEL)),
        'w_in': nrm(ks[3], (N_EVEN, D_MODEL, IN_COLS), D_MODEL ** -0.5),
        'q_norm': gain(ks[4], (N_EVEN, DIFF_QK_DIM)),
        'k_norm': gain(ks[5], (N_EVEN, DIFF_QK_DIM)),
        'lambda_q1': nrm(ks[6], (N_EVEN, DIFF_QK_DIM), 0.1),
        'lambda_k1': nrm(ks[7], (N_EVEN, DIFF_QK_DIM), 0.1),
        'lambda_q2': nrm(ks[8], (N_EVEN, DIFF_QK_DIM), 0.1),
        'lambda_k2': nrm(ks[9], (N_EVEN, DIFF_QK_DIM), 0.1),
        'attn_subln': gain(ks[10], (N_EVEN, DIFF_V_DIM)),
        'conv_w': nrm(ks[11], (N_EVEN, SSD_CONV, SSD_CONV_CH), SSD_CONV ** -0.5),
        'conv_b': nrm(ks[12], (N_EVEN, SSD_CONV_CH), 0.02),
        'dt_bias': dt_bias,
        'a_log': a_log,
        'd_skip': gain(ks[15], (N_EVEN, SSD_HEADS)),
        'ssd_norm': gain(ks[16], (N_EVEN, SSD_WIDTH)),
        'w_out': nrm(ks[17], (N_EVEN, MIX_WIDTH, D_MODEL), MIX_WIDTH ** -0.5),
        'w_fourier': nrm(ks[18], (N_ODD, D_MODEL, D_MODEL), D_MODEL ** -0.5),
        'router_group_w': nrm(ks[19], (DEPTH, D_MODEL, MOE_GROUPS), D_MODEL ** -0.5),
        'router_group_b': nrm(ks[20], (DEPTH, MOE_GROUPS), 0.01),
        'router_expert_w': nrm(ks[21], (DEPTH, D_MODEL, MOE_GROUPS, MOE_EXPERTS_PER_GROUP), D_MODEL ** -0.5),
        'router_expert_b': nrm(ks[22], (DEPTH, MOE_GROUPS, MOE_EXPERTS_PER_GROUP), 0.01),
        'expert_w1': nrm(ks[23], (DEPTH, MOE_EXPERTS, D_MODEL, MOE_HIDDEN), D_MODEL ** -0.5),
        'expert_w3': nrm(ks[24], (DEPTH, MOE_EXPERTS, D_MODEL, MOE_HIDDEN), D_MODEL ** -0.5),
        'expert_w2': nrm(ks[25], (DEPTH, MOE_EXPERTS, MOE_HIDDEN, D_MODEL), MOE_HIDDEN ** -0.5),
    }


def reference(x, norm_mix, norm_ffn, w_in, q_norm, k_norm, lambda_q1, lambda_k1, lambda_q2, lambda_k2,
              attn_subln, conv_w, conv_b, dt_bias, a_log, d_skip, ssd_norm, w_out, w_fourier,
              router_group_w, router_group_b, router_expert_w, router_expert_b,
              expert_w1, expert_w3, expert_w2):
    for l in range(DEPTH):
        i = l // 2
        h = rmsnorm(x, norm_mix[l])
        if l % 2 == 0:
            lambda_init = 0.8 - 0.6 * math.exp(-0.3 * l)
            x = x + diff_ssd_mixer(h, w_in[i], q_norm[i], k_norm[i], lambda_q1[i], lambda_k1[i],
                                   lambda_q2[i], lambda_k2[i], attn_subln[i], conv_w[i], conv_b[i],
                                   dt_bias[i], a_log[i], d_skip[i], ssd_norm[i], w_out[i], lambda_init)
        else:
            x = x + fourier_mixer(h, w_fourier[i])
        h = rmsnorm(x, norm_ffn[l])
        x = x + hier_moe(h, router_group_w[l], router_group_b[l], router_expert_w[l], router_expert_b[l],
                         expert_w1[l], expert_w3[l], expert_w2[l])
    return x
```

```cpp
#include <hip/hip_runtime.h>
#include <hip/hip_cooperative_groups.h>
#include <cstdio>
namespace cg = cooperative_groups;

#ifndef REP_MASK
#define REP_MASK 0u
#endif
#ifndef MK_ONE_LAUNCH
#define MK_ONE_LAUNCH 1
#endif

constexpr int D = 1024, NB = 16, SEQ = 2048, T = NB * SEQ;
constexpr int INC = 2832;
constexpr int KOFF = 512, VOFF = 1024, ZOFF = 1536, XOFF = 2048, DTOFF = 2816;
constexpr int NE = 32, HID = 256;
constexpr int NPHASE = 19;
constexpr int CAP = 32768;
constexpr float EPS = 1e-6f;


__device__ __forceinline__ float shidx(float v, int src) { return __int_as_float(__builtin_amdgcn_ds_bpermute(src << 2, __float_as_int(v))); }
__device__ __forceinline__ float shx(float v, int o, int lane) { return shidx(v, lane ^ o); }
__device__ __forceinline__ float wave_sum(float v, int lane) {
#pragma unroll
    for (int o = 32; o > 0; o >>= 1) v += shx(v, o, lane);
    return v;
}
namespace mk {
#define MK_LAS __attribute__((address_space(3)))
typedef unsigned short bf16_t;
typedef short bf16x8 __attribute__((ext_vector_type(8)));
typedef float f32x4 __attribute__((ext_vector_type(4)));
typedef unsigned u32x4 __attribute__((ext_vector_type(4)));
typedef unsigned u32x2 __attribute__((ext_vector_type(2)));
constexpr int BM = 256, BK = 64, HALF = 128, HTB = HALF * BK * 2, STAGE_BYTES = 8 * HTB;

__host__ __device__ __forceinline__ int lds_byte(int r, int c) { const int st = (r >> 4) * 2 + (c >> 5), rr = r & 15, cc = c & 31, ob = rr * 64 + cc * 2; return st * 1024 + (ob ^ (((ob >> 9) & 1) << 5)); }
__host__ __device__ __forceinline__ void stage_rc(int b, int& R, int& C) { const int st = b / 1024, sb = b % 1024, swz = sb ^ (((sb >> 9) & 1) << 5); R = (st >> 1) * 16 + swz / 64; C = (st & 1) * 32 + (swz % 64) / 2; }
__host__ __device__ __forceinline__ int perm32(int rho) { const int n = rho >> 4, i = rho & 15; return 8 * (i >> 2) + 4 * n + (i & 3); }

__device__ __forceinline__ unsigned cvt_pk_bf16(float lo, float hi) { unsigned r; asm volatile("v_cvt_pk_bf16_f32 %0, %1, %2" : "=v"(r) : "v"(lo), "v"(hi)); return r; }
__device__ __forceinline__ float bf2f(bf16_t v) { return __uint_as_float(((unsigned)v) << 16); }
__device__ __forceinline__ bf16_t f2bf(float f) { unsigned u = __float_as_uint(f); u += 0x7FFFu + ((u >> 16) & 1u); return (bf16_t)(u >> 16); }

struct Unit { const char* a; const char* b; const int4* lst; int pm, pn, aux, nvalid, bj; };

__device__ __forceinline__ const char* uni_ptr(const char* p) { const unsigned lo = __builtin_amdgcn_readfirstlane((unsigned)(uintptr_t)p), hi = __builtin_amdgcn_readfirstlane((unsigned)((uintptr_t)p >> 32)); return (const char*)(((uintptr_t)hi << 32) | lo); }
__device__ __forceinline__ void uni_unit(Unit& u) { u.a = uni_ptr(u.a); u.b = uni_ptr(u.b); u.lst = (const int4*)uni_ptr((const char*)u.lst);
    u.pm = __builtin_amdgcn_readfirstlane(u.pm); u.pn = __builtin_amdgcn_readfirstlane(u.pn); u.aux = __builtin_amdgcn_readfirstlane(u.aux); u.nvalid = __builtin_amdgcn_readfirstlane(u.nvalid); }
struct BMapNat  { static __device__ __forceinline__ int row(int h, int R) { return h * 128 + R; } };
struct BMapPerm { static __device__ __forceinline__ int row(int h, int R) { return h * 128 + (R & ~31) + perm32(R & 31); } };
struct BMapUp   { static __device__ __forceinline__ int row(int h, int R) { return h * 256 + (R & ~31) + perm32(R & 31); } };
struct BMapQK   { static __device__ __forceinline__ int row(int h, int R) { return 64 * (R >> 5) + 32 * h + perm32(R & 31); } };

template <class Epi, class Sched, bool ALIGN_EPI = true, bool SP2 = true>
__device__ __forceinline__ void gemm_phase(MK_LAS unsigned char* lds, const int K, const int lda, const int ldb, const Sched& S, const Epi& E) {
    int tid = threadIdx.x; asm volatile("" : "+v"(tid));
    const int wid = __builtin_amdgcn_readfirstlane(tid >> 6), lane = tid & 63, wr = wid >> 2, wc = wid & 3, fr = lane & 15, fq = lane >> 4;
    int nt = K / BK; asm volatile("" : "+s"(nt));
    int RA[2], CA[2];
    unsigned voffB[2][2], voffA[2][2], voffAn[2][2];
#pragma unroll
    for (int i = 0; i < 2; ++i) { stage_rc(tid * 16 + i * 8192, RA[i], CA[i]); }
#pragma unroll
    for (int h = 0; h < 2; ++h)
#pragma unroll
        for (int i = 0; i < 2; ++i) voffB[h][i] = (unsigned)(Epi::BMap::row(h, RA[i]) * ldb + CA[i]) * 2u;
    const size_t kstep = (size_t)(BK * 2);
    const unsigned ldsw = (unsigned)wid * 1024u;
    const int aoff = lds_byte(wr * 64 + fr, fq * 8), boff = lds_byte(wc * 32 + fr, fq * 8);
#define MK_SA(b, h) (((b) * 2 + (h)) * HTB)
#define MK_SB(b, h) ((4 + (b) * 2 + (h)) * HTB)
#define MK_STAGE(bufoff, gbase, voff) do { _Pragma("unroll") for (int _i = 0; _i < 2; ++_i) \
        __builtin_amdgcn_global_load_lds((const unsigned*)((const char*)(gbase) + (voff)[_i]), (MK_LAS unsigned*)(lds + (bufoff) + ldsw + _i * 8192), 16, 0, 0); } while (0)
#define MK_LDA(dst, b, h) do { _Pragma("unroll") for (int m = 0; m < 4; ++m) _Pragma("unroll") for (int k = 0; k < 2; ++k) dst[m][k] = *(const MK_LAS bf16x8*)(lds + MK_SA(b, h) + aoff + m * 2048 + k * 1024); } while (0)
#define MK_LDB(dst, b, h) do { _Pragma("unroll") for (int n = 0; n < 2; ++n) _Pragma("unroll") for (int k = 0; k < 2; ++k) dst[n][k] = *(const MK_LAS bf16x8*)(lds + MK_SB(b, h) + boff + n * 2048 + k * 1024); } while (0)
#define MK_MMA(ai, bj, At, Bt) do { __builtin_amdgcn_s_setprio(1); _Pragma("unroll") for (int m = 0; m < 4; ++m) _Pragma("unroll") for (int n = 0; n < 2; ++n) _Pragma("unroll") for (int k = 0; k < 2; ++k) \
        acc[ai][bj][m][n] = __builtin_amdgcn_mfma_f32_16x16x32_bf16(Bt[n][k], At[m][k], acc[ai][bj][m][n], 0, 0, 0); __builtin_amdgcn_s_setprio(0); } while (0)
#define MK_WAIT_V(n) asm volatile("s_waitcnt vmcnt(" #n ")" ::: "memory")
#define MK_WAIT_L(n) asm volatile("s_waitcnt lgkmcnt(" #n ")" ::: "memory")
#define MK_BAR __builtin_amdgcn_s_barrier()
#define MK_SCHED __builtin_amdgcn_sched_barrier(0)
#define MK_SETA(dst, u) do { int _t = threadIdx.x; asm volatile("" : "+v"(_t)); _Pragma("unroll") for (int _i = 0; _i < 2; ++_i) { int _R, _C; stage_rc(_t * 16 + _i * 8192, _R, _C); _Pragma("unroll") for (int _h = 0; _h < 2; ++_h) dst[_h][_i] = (unsigned)(S.arow(u, _h * 128 + _R) * lda + _C) * 2u; } } while (0)
    Unit cur, nxt; int ui = 0;
    if (!S.next(0, cur)) return;
    uni_unit(cur); if constexpr (Sched::BJUMP) cur.bj = __builtin_amdgcn_readfirstlane(cur.bj);
    f32x4 acc[2][2][4][2];
#pragma unroll
    for (int a = 0; a < 2; ++a)
#pragma unroll
        for (int b = 0; b < 2; ++b)
#pragma unroll
            for (int m = 0; m < 4; ++m)
#pragma unroll
                for (int n = 0; n < 2; ++n) acc[a][b][m][n] = (f32x4){0.f, 0.f, 0.f, 0.f};
    bf16x8 At[4][2], B0[2][2], B1[2][2];
    const char* cA = cur.a; const char* cB = cur.b;
    MK_SETA(voffA, cur);
    if constexpr (SP2) {
        MK_STAGE(MK_SB(0, 0), cB, voffB[0]); MK_STAGE(MK_SB(0, 1), cB, voffB[1]); MK_STAGE(MK_SA(0, 0), cA, voffA[0]); MK_STAGE(MK_SA(0, 1), cA, voffA[1]);
        if (wr == 1) MK_BAR;
        MK_WAIT_V(2); MK_BAR;
        MK_STAGE(MK_SB(1, 0), cB + kstep, voffB[0]); MK_STAGE(MK_SA(1, 0), cA + kstep, voffA[0]); MK_STAGE(MK_SB(1, 1), cB + kstep, voffB[1]);
        MK_WAIT_V(6); MK_BAR;
    } else {
    MK_STAGE(MK_SB(0, 0), cB, voffB[0]); MK_STAGE(MK_SA(0, 0), cA, voffA[0]); MK_STAGE(MK_SB(0, 1), cB, voffB[1]); MK_STAGE(MK_SA(0, 1), cA, voffA[1]);
    if (wr == 1) MK_BAR;
    MK_WAIT_V(4); MK_BAR;
    MK_STAGE(MK_SB(1, 0), cB + kstep, voffB[0]); MK_STAGE(MK_SA(1, 0), cA + kstep, voffA[0]); MK_STAGE(MK_SB(1, 1), cB + kstep, voffB[1]);
    MK_WAIT_V(6); MK_BAR;
    }
    for (;;) {
        bool has_next = S.next(ui + 1, nxt);
        has_next = __builtin_amdgcn_readfirstlane((int)has_next) != 0; if (has_next) { uni_unit(nxt); if constexpr (Sched::BJUMP) nxt.bj = __builtin_amdgcn_readfirstlane(nxt.bj); }
        if constexpr (Sched::GATHER) { if (has_next) { MK_SETA(voffAn, nxt); } }
        const char* nA = has_next ? nxt.a : cA; const char* nB = has_next ? nxt.b : cB;

#pragma unroll 1
        for (int t = 0; t < nt; t += 2) {
            const bool last = (t == nt - 2);
            const char* a1 = cA + (size_t)(t + 1) * kstep;
            const char* a2 = last ? nA : cA + (size_t)(t + 2) * kstep; const char* b2 = last ? nB : cB + (size_t)(t + 2) * kstep;
            if constexpr (Sched::BJUMP) { if (!last && t >= 2) b2 += cur.bj; }
            const char* a3 = a2 + kstep; const char* b3 = b2 + kstep;
            if constexpr (SP2) {
            MK_LDB(B0, 0, 0); MK_LDB(B1, 0, 1); MK_SCHED; MK_LDA(At, 0, 0); MK_STAGE(MK_SA(1, 1), a1, voffA[1]);
            if constexpr (Sched::GATHER) { if (last && has_next) {
#pragma unroll
                for (int h = 0; h < 2; ++h)
#pragma unroll
                    for (int i = 0; i < 2; ++i) voffA[h][i] = voffAn[h][i]; } }
            MK_WAIT_V(8); MK_WAIT_L(0); MK_BAR; MK_MMA(0, 0, At, B0); MK_MMA(0, 1, At, B1); MK_BAR; MK_SCHED;
            MK_LDA(At, 0, 1); MK_STAGE(MK_SB(0, 0), b2, voffB[0]); MK_STAGE(MK_SB(0, 1), b2, voffB[1]); MK_STAGE(MK_SA(0, 0), a2, voffA[0]);
            MK_WAIT_V(8); MK_WAIT_L(0); MK_BAR; MK_MMA(1, 0, At, B0); MK_MMA(1, 1, At, B1); MK_BAR; MK_SCHED;
            MK_LDB(B0, 1, 0); MK_LDB(B1, 1, 1); MK_SCHED; MK_LDA(At, 1, 0); MK_STAGE(MK_SA(0, 1), a2, voffA[1]);
            MK_WAIT_V(8); MK_WAIT_L(0); MK_BAR; MK_MMA(0, 0, At, B0); MK_MMA(0, 1, At, B1); MK_BAR; MK_SCHED;
            MK_LDA(At, 1, 1); MK_STAGE(MK_SB(1, 0), b3, voffB[0]); MK_STAGE(MK_SB(1, 1), b3, voffB[1]); MK_STAGE(MK_SA(1, 0), a3, voffA[0]);
            MK_WAIT_V(8); MK_WAIT_L(0); MK_BAR; MK_MMA(1, 0, At, B0); MK_MMA(1, 1, At, B1); MK_BAR; MK_SCHED;
            } else {
            MK_LDB(B0, 0, 0); MK_SCHED; MK_LDA(At, 0, 0); MK_STAGE(MK_SA(1, 1), a1, voffA[1]);
            if constexpr (Sched::GATHER) { if (last && has_next) {
#pragma unroll
                for (int h = 0; h < 2; ++h)
#pragma unroll
                    for (int i = 0; i < 2; ++i) voffA[h][i] = voffAn[h][i]; } }
            MK_WAIT_L(8); MK_BAR; MK_WAIT_L(0); MK_MMA(0, 0, At, B0); MK_BAR; MK_SCHED;
            MK_LDB(B1, 0, 1); MK_STAGE(MK_SB(0, 0), b2, voffB[0]);
            MK_BAR; MK_WAIT_L(0); MK_MMA(0, 1, At, B1); MK_BAR;
            MK_LDA(At, 0, 1); MK_STAGE(MK_SA(0, 0), a2, voffA[0]);
            MK_BAR; MK_WAIT_L(0); MK_MMA(1, 0, At, B0); MK_BAR; MK_SCHED;
            MK_STAGE(MK_SB(0, 1), b2, voffB[1]);
            MK_WAIT_V(6); MK_BAR; MK_MMA(1, 1, At, B1); MK_BAR;
            MK_LDB(B0, 1, 0); MK_SCHED; MK_LDA(At, 1, 0); MK_STAGE(MK_SA(0, 1), a2, voffA[1]);
            MK_WAIT_L(8); MK_BAR; MK_WAIT_L(0); MK_MMA(0, 0, At, B0); MK_BAR; MK_SCHED;
            MK_LDB(B1, 1, 1); MK_STAGE(MK_SB(1, 0), b3, voffB[0]);
            MK_BAR; MK_WAIT_L(0); MK_MMA(0, 1, At, B1); MK_BAR;
            MK_LDA(At, 1, 1); MK_STAGE(MK_SA(1, 0), a3, voffA[0]);
            MK_BAR; MK_WAIT_L(0); MK_MMA(1, 0, At, B0); MK_BAR; MK_SCHED;
            MK_STAGE(MK_SB(1, 1), b3, voffB[1]);
            MK_WAIT_V(6); MK_BAR; MK_MMA(1, 1, At, B1); MK_BAR;
            }
        }
        if constexpr (ALIGN_EPI) { if (wr == 0) MK_BAR; }
        { int fr2 = fr, fq2 = fq; asm volatile("" : "+v"(fr2), "+v"(fq2)); E(acc, cur, wr, wc, fr2, fq2); }
        if (!has_next) break;
#pragma unroll
        for (int a = 0; a < 2; ++a)
#pragma unroll
            for (int b = 0; b < 2; ++b)
#pragma unroll
                for (int m = 0; m < 4; ++m)
#pragma unroll
                    for (int n = 0; n < 2; ++n) acc[a][b][m][n] = (f32x4){0.f, 0.f, 0.f, 0.f};
        cur = nxt; cA = nA; cB = nB; ++ui;
        if constexpr (ALIGN_EPI) { if (wr == 1) MK_BAR; }
    }
    MK_WAIT_V(0);
    if constexpr (!ALIGN_EPI) { if (wr == 0) MK_BAR; }
    MK_BAR;
#undef MK_SA
#undef MK_SB
#undef MK_STAGE
#undef MK_LDA
#undef MK_LDB
#undef MK_MMA
#undef MK_WAIT_V
#undef MK_WAIT_L
#undef MK_BAR
#undef MK_SCHED
#undef MK_SETA
}

struct SchedGrid {
    static constexpr bool GATHER = false; static constexpr bool BJUMP = false;
    const char* A; const char* Bt; int nM, nN, lda, ldb;
    __device__ __forceinline__ bool next(int i, Unit& u) const {
        const long L = (long)i * gridDim.x + blockIdx.x; const int nwg = nM * nN; if (L >= (long)nwg) return false;
        int wgid = (int)L; { const int q = nwg / 8, r = nwg % 8, xcd = wgid % 8, off = wgid / 8; wgid = (xcd < r ? xcd * (q + 1) : r * (q + 1) + (xcd - r) * q) + off; }
        const int nig = 8 * nN, gid = wgid / nig, fm = gid * 8, gsz = (nM - fm) < 8 ? (nM - fm) : 8;
        const int pm = fm + ((wgid % nig) % gsz), pn = (wgid % nig) / gsz;
        u.pm = pm; u.pn = pn; u.aux = 0; u.nvalid = 256; u.lst = nullptr; u.a = A + (size_t)pm * 256 * lda * 2; u.b = Bt + (size_t)pn * 256 * ldb * 2; return true;
    }
    __device__ __forceinline__ int arow(const Unit&, int r) const { return r; }
};
}

namespace at {
using bf16x8 = __attribute__((ext_vector_type(8))) short;
using s16x4  = __attribute__((ext_vector_type(4))) short;
using f32x16 = __attribute__((ext_vector_type(16))) float;
using u32x4  = __attribute__((ext_vector_type(4))) unsigned;
constexpr int KVBLK = 64, LDK = 512;
constexpr float C2 = 0.125f * 1.4426950408889634f;
constexpr float THR2 = 8.f * 1.4426950408889634f;
constexpr size_t SHM_V = KVBLK * 128 * 2, SHM_K = KVBLK * 64 * 2;
#define AT_KSWZ(row, colB) ((row) * 128 + ((colB) ^ ((((row) >> 1) & 7) << 4)))
#define AT_SBAR() __builtin_amdgcn_sched_barrier(0)
__device__ __forceinline__ int crow(int r, int hi) { return (r & 3) + 8 * (r >> 2) + 4 * hi; }
__device__ __forceinline__ unsigned cvtpk(float lo, float hi) { unsigned r; asm volatile("v_cvt_pk_bf16_f32 %0, %1, %2" : "=v"(r) : "v"(lo), "v"(hi)); return r; }

template <int MODE> __device__ __forceinline__ void smA(f32x16& p0, f32x16& p1, float base, float sl2, float slq, float Aq) {
#pragma unroll
  for (int r = 0; r < 16; ++r) { const float c = (float)((r & 3) + 8 * (r >> 2));
    if (MODE == 0) { p0[r] = fmaf(p0[r], C2, fmaf(c, slq, Aq)); p1[r] = fmaf(p1[r], C2, fmaf(c + 32.f, slq, Aq)); }
    else { p0[r] = fmaf(p0[r], C2, -sl2 * fabsf(base - c)); p1[r] = fmaf(p1[r], C2, -sl2 * fabsf(base - c - 32.f)); } }
#pragma unroll
  for (int r = 0; r < 16; ++r) p0[r] = __builtin_amdgcn_exp2f(p0[r]);
}
__device__ __forceinline__ void partialSM(f32x16& p0, f32x16& p1, float base, float sl2) {
  const int lo = __builtin_amdgcn_readfirstlane((int)base);
  if (lo >= 63) smA<0>(p0, p1, base, sl2, sl2, -sl2 * base);
  else if (lo <= -31) smA<0>(p0, p1, base, sl2, -sl2, sl2 * base);
  else smA<1>(p0, p1, base, sl2, 0.f, 0.f);
}
__device__ __forceinline__ void finishSM(f32x16& p0, f32x16& p1, float& l_reg, bf16x8& pa0, bf16x8& pa1, bf16x8& pa2, bf16x8& pa3) {
#pragma unroll
  for (int r = 0; r < 16; ++r) p1[r] = __builtin_amdgcn_exp2f(p1[r]);
  float ps = 0;
#pragma unroll
  for (int r = 0; r < 16; ++r) ps += p0[r];
#pragma unroll
  for (int r = 0; r < 16; ++r) ps += p1[r];
  { auto rr = __builtin_amdgcn_permlane32_swap(__float_as_uint(ps), __float_as_uint(ps), false, false);
    ps = __uint_as_float(rr[0]) + __uint_as_float(rr[1]); }
  l_reg += ps;
#define AT_PK4(P, BASE, OUT) do { unsigned a0 = cvtpk(P[BASE + 0], P[BASE + 1]), a1 = cvtpk(P[BASE + 2], P[BASE + 3]);   \
    unsigned b0 = cvtpk(P[BASE + 4], P[BASE + 5]), b1 = cvtpk(P[BASE + 6], P[BASE + 7]);                              \
    auto r0 = __builtin_amdgcn_permlane32_swap(a0, b0, false, false); auto r1 = __builtin_amdgcn_permlane32_swap(a1, b1, false, false); \
    u32x4 w = {r0[0], r1[0], r0[1], r1[1]}; OUT = *reinterpret_cast<bf16x8*>(&w); } while (0)
  AT_PK4(p0, 0, pa0); AT_PK4(p0, 8, pa1); AT_PK4(p1, 0, pa2); AT_PK4(p1, 8, pa3);
#undef AT_PK4
}
__device__ __forceinline__ void qkt(f32x16& p0, f32x16& p1, const char* Ks, const bf16x8* qr, int r32, int hi) {
  p0 = f32x16{}; p1 = f32x16{};
#pragma unroll
  for (int d0 = 0; d0 < 4; ++d0) { const int cb = (d0 * 16 + hi * 8) * 2;
    bf16x8 b0 = *reinterpret_cast<const bf16x8*>(Ks + AT_KSWZ(r32, cb));
    bf16x8 b1 = *reinterpret_cast<const bf16x8*>(Ks + AT_KSWZ(32 + r32, cb));
    p0 = __builtin_amdgcn_mfma_f32_32x32x16_bf16(b0, qr[d0], p0, 0, 0, 0);
    p1 = __builtin_amdgcn_mfma_f32_32x32x16_bf16(b1, qr[d0], p1, 0, 0, 0); }
}
__device__ __forceinline__ int v_st(int k, int c) { const int kk = (k & ~0xC) | ((k & 4) << 1) | ((k & 8) >> 1); return ((kk >> 3) * 4 + (c >> 5)) * 512 + ((kk & 7) * 32 + (c & 31)) * 2; }
__device__ __forceinline__ int v_rd_base(int lane) { return ((lane & 3) << 3) | (((lane >> 2) & 3) << 6) | (((lane >> 4) & 1) << 5) | (((lane >> 5) & 1) << 8); }
constexpr int v_rd_off(int d0, int ks, int half) { return d0 * 512 + ks * 4096 + half * 2048; }
template <int OFF> __device__ __forceinline__ s16x4 tr_read(int vb) {
  s16x4 r; asm volatile("ds_read_b64_tr_b16 %0, %1 offset:%2" : "=&v"(r) : "v"(vb), "i"(OFF) : "memory"); return r;
}
template <int D0> __device__ __forceinline__ void pv_one(f32x16& od, int vb, bf16x8 pa0, bf16x8 pa1, bf16x8 pa2, bf16x8 pa3) {
  const s16x4 l0 = tr_read<v_rd_off(D0, 0, 0)>(vb), h0 = tr_read<v_rd_off(D0, 0, 1)>(vb), l1 = tr_read<v_rd_off(D0, 1, 0)>(vb), h1 = tr_read<v_rd_off(D0, 1, 1)>(vb);
  const s16x4 l2 = tr_read<v_rd_off(D0, 2, 0)>(vb), h2 = tr_read<v_rd_off(D0, 2, 1)>(vb), l3 = tr_read<v_rd_off(D0, 3, 0)>(vb), h3 = tr_read<v_rd_off(D0, 3, 1)>(vb);
  asm volatile("s_waitcnt lgkmcnt(0)" ::: "memory"); AT_SBAR();
#define AT_PK(L, H) __builtin_shufflevector(L, H, 0, 1, 2, 3, 4, 5, 6, 7)
  od = __builtin_amdgcn_mfma_f32_32x32x16_bf16(pa0, AT_PK(l0, h0), od, 0, 0, 0);
  od = __builtin_amdgcn_mfma_f32_32x32x16_bf16(pa1, AT_PK(l1, h1), od, 0, 0, 0);
  od = __builtin_amdgcn_mfma_f32_32x32x16_bf16(pa2, AT_PK(l2, h2), od, 0, 0, 0);
  od = __builtin_amdgcn_mfma_f32_32x32x16_bf16(pa3, AT_PK(l3, h3), od, 0, 0, 0);
#undef AT_PK
}
__device__ __forceinline__ void pv_d0(f32x16* o, int vb, bf16x8 pa0, bf16x8 pa1, bf16x8 pa2, bf16x8 pa3) {
  pv_one<0>(o[0], vb, pa0, pa1, pa2, pa3); pv_one<1>(o[1], vb, pa0, pa1, pa2, pa3); pv_one<2>(o[2], vb, pa0, pa1, pa2, pa3); pv_one<3>(o[3], vb, pa0, pa1, pa2, pa3);
}


typedef float f32x2 __attribute__((ext_vector_type(2)));
typedef __bf16 bf16x2v __attribute__((ext_vector_type(2)));
__device__ __forceinline__ unsigned cvtpk_b(float lo, float hi) { const f32x2 v = {lo, hi}; return __builtin_bit_cast(unsigned, __builtin_convertvector(v, bf16x2v)); }
#define AT_SWAP(a, b) __builtin_amdgcn_permlane32_swap(a, b, false, false)
__device__ __forceinline__ void qkt_fin(f32x16& n0, f32x16& n1, const char* Ks, const bf16x8* qr, int r32, int hi,
                                        f32x16& p0, f32x16& p1, float& l_reg, bf16x8& pa0, bf16x8& pa1, bf16x8& pa2, bf16x8& pa3) {
  n0 = f32x16{}; n1 = f32x16{};
  f32x2 s2 = {0.f, 0.f};
  unsigned c0 = 0, c1 = 0, c2 = 0, c3 = 0;
  bf16x8 b0 = *reinterpret_cast<const bf16x8*>(Ks + AT_KSWZ(r32, (hi * 8) * 2)), b1 = *reinterpret_cast<const bf16x8*>(Ks + AT_KSWZ(32 + r32, (hi * 8) * 2));
#pragma unroll
  for (int d0 = 0; d0 < 4; ++d0) {
    bf16x8 nb0 = b0, nb1 = b1;
    if (d0 < 3) { const int cb = ((d0 + 1) * 16 + hi * 8) * 2; nb0 = *reinterpret_cast<const bf16x8*>(Ks + AT_KSWZ(r32, cb)); nb1 = *reinterpret_cast<const bf16x8*>(Ks + AT_KSWZ(32 + r32, cb)); }
    AT_SBAR();
    n0 = __builtin_amdgcn_mfma_f32_32x32x16_bf16(b0, qr[d0], n0, 0, 0, 0);
    AT_SBAR();
    {
      const int g = 2 * d0;
      p1[2 * g] = __builtin_amdgcn_exp2f(p1[2 * g]); p1[2 * g + 1] = __builtin_amdgcn_exp2f(p1[2 * g + 1]);
      s2 += (f32x2){p0[2 * g], p0[2 * g + 1]};
      if (g > 0) s2 += (f32x2){p1[2 * g - 2], p1[2 * g - 1]};
      if (g == 0) { c0 = cvtpk_b(p0[0], p0[1]); c1 = cvtpk_b(p0[2], p0[3]); }
      if (g == 2) { c0 = cvtpk_b(p0[8], p0[9]); c1 = cvtpk_b(p0[10], p0[11]); }
      if (g == 4) { c0 = cvtpk_b(p1[0], p1[1]); c1 = cvtpk_b(p1[2], p1[3]); }
      if (g == 6) { c0 = cvtpk_b(p1[8], p1[9]); c1 = cvtpk_b(p1[10], p1[11]); }
      asm volatile("" : "+v"(s2));
    }
    AT_SBAR();
    n1 = __builtin_amdgcn_mfma_f32_32x32x16_bf16(b1, qr[d0], n1, 0, 0, 0);
    AT_SBAR();
    {
      const int g = 2 * d0 + 1;
      p1[2 * g] = __builtin_amdgcn_exp2f(p1[2 * g]); p1[2 * g + 1] = __builtin_amdgcn_exp2f(p1[2 * g + 1]);
      s2 += (f32x2){p0[2 * g], p0[2 * g + 1]};
      s2 += (f32x2){p1[2 * g - 2], p1[2 * g - 1]};
      if (g == 1) { c2 = cvtpk_b(p0[4], p0[5]); c3 = cvtpk_b(p0[6], p0[7]); }
      if (g == 3) { c2 = cvtpk_b(p0[12], p0[13]); c3 = cvtpk_b(p0[14], p0[15]); }
      if (g == 5) { c2 = cvtpk_b(p1[4], p1[5]); c3 = cvtpk_b(p1[6], p1[7]); }
      if (g < 7) { const auto r0 = AT_SWAP(c0, c2); const auto r1 = AT_SWAP(c1, c3); const u32x4 w = {r0[0], r1[0], r0[1], r1[1]};
        if (g == 1) pa0 = __builtin_bit_cast(bf16x8, w); if (g == 3) pa1 = __builtin_bit_cast(bf16x8, w); if (g == 5) pa2 = __builtin_bit_cast(bf16x8, w); }
      asm volatile("" : "+v"(s2));
    }
    AT_SBAR();
    b0 = nb0; b1 = nb1;
  }
  {
    c2 = cvtpk_b(p1[12], p1[13]); c3 = cvtpk_b(p1[14], p1[15]);
    const auto r0 = AT_SWAP(c0, c2); const auto r1 = AT_SWAP(c1, c3); const u32x4 w = {r0[0], r1[0], r0[1], r1[1]}; pa3 = __builtin_bit_cast(bf16x8, w);
    s2 += (f32x2){p1[14], p1[15]};
    float ps = s2[0] + s2[1];
    const auto rr = AT_SWAP(__float_as_uint(ps), __float_as_uint(ps));
    l_reg += __uint_as_float(rr[0]) + __uint_as_float(rr[1]);
  }
}
template <int KS> __device__ __forceinline__ void v_group(int vb, s16x4 (&f)[8]) {
  f[0] = tr_read<v_rd_off(0, KS, 0)>(vb); f[1] = tr_read<v_rd_off(0, KS, 1)>(vb); f[2] = tr_read<v_rd_off(1, KS, 0)>(vb); f[3] = tr_read<v_rd_off(1, KS, 1)>(vb);
  f[4] = tr_read<v_rd_off(2, KS, 0)>(vb); f[5] = tr_read<v_rd_off(2, KS, 1)>(vb); f[6] = tr_read<v_rd_off(3, KS, 0)>(vb); f[7] = tr_read<v_rd_off(3, KS, 1)>(vb);
}
#define AT_VWAIT(N, f) asm volatile("s_waitcnt lgkmcnt(" #N ")" : "+v"(f[0]), "+v"(f[1]), "+v"(f[2]), "+v"(f[3]), "+v"(f[4]), "+v"(f[5]), "+v"(f[6]), "+v"(f[7]) :: "memory")
template <int C> __device__ __forceinline__ void psm_slice(f32x16& p0, f32x16& p1, float sl2, float Aq) {
  constexpr int E = 2 * (C & 7);
  constexpr float k0 = (float)((E & 3) + 8 * (E >> 2) + (C >= 8 ? 32 : 0)), k1 = (float)(((E + 1) & 3) + 8 * ((E + 1) >> 2) + (C >= 8 ? 32 : 0));
  const f32x2 kk = {k0, k1}, sl = {sl2, sl2}, aq = {Aq, Aq};
  f32x2 t = __builtin_elementwise_fma(kk, sl, aq);
  float a0 = C < 8 ? p0[E] : p1[E], a1 = C < 8 ? p0[E + 1] : p1[E + 1];
  a0 = fmaf(a0, C2, -fabsf(t[0])); a1 = fmaf(a1, C2, -fabsf(t[1]));
  asm volatile("" : "+v"(a0), "+v"(a1));
  if (C < 8) { p0[E] = a0; p0[E + 1] = a1; } else { p1[E] = a0; p1[E + 1] = a1; }
  p0[C] = __builtin_amdgcn_exp2f(p0[C]);
}
#define AT_PVG(PA, F, KS) do { \
    o[0] = __builtin_amdgcn_mfma_f32_32x32x16_bf16(PA, __builtin_shufflevector(F[0], F[1], 0, 1, 2, 3, 4, 5, 6, 7), o[0], 0, 0, 0); AT_SBAR(); psm_slice<4 * KS + 0>(p0, p1, sl2, Aq); AT_SBAR(); \
    o[1] = __builtin_amdgcn_mfma_f32_32x32x16_bf16(PA, __builtin_shufflevector(F[2], F[3], 0, 1, 2, 3, 4, 5, 6, 7), o[1], 0, 0, 0); AT_SBAR(); psm_slice<4 * KS + 1>(p0, p1, sl2, Aq); AT_SBAR(); \
    o[2] = __builtin_amdgcn_mfma_f32_32x32x16_bf16(PA, __builtin_shufflevector(F[4], F[5], 0, 1, 2, 3, 4, 5, 6, 7), o[2], 0, 0, 0); AT_SBAR(); psm_slice<4 * KS + 2>(p0, p1, sl2, Aq); AT_SBAR(); \
    o[3] = __builtin_amdgcn_mfma_f32_32x32x16_bf16(PA, __builtin_shufflevector(F[6], F[7], 0, 1, 2, 3, 4, 5, 6, 7), o[3], 0, 0, 0); AT_SBAR(); psm_slice<4 * KS + 3>(p0, p1, sl2, Aq); AT_SBAR(); } while (0)
__device__ __forceinline__ void pv_psm(f32x16* o, int vb, bf16x8 pa0, bf16x8 pa1, bf16x8 pa2, bf16x8 pa3, f32x16& p0, f32x16& p1, float sl2, float Aq) {
  s16x4 fa[8], fb[8];
  v_group<0>(vb, fa); v_group<1>(vb, fb); AT_VWAIT(8, fa);
  AT_PVG(pa0, fa, 0);
  v_group<2>(vb, fa); AT_VWAIT(8, fb);
  AT_PVG(pa1, fb, 1);
  v_group<3>(vb, fb); AT_VWAIT(8, fa);
  AT_PVG(pa2, fa, 2);
  AT_VWAIT(0, fb);
  AT_PVG(pa3, fb, 3);
}

__device__ __forceinline__ void attn_pass(const unsigned short* __restrict__ Qw, const unsigned short* __restrict__ Kh, const unsigned short* __restrict__ Vh,
                                          f32x16 (&o)[4], float& l_out, float* ws, int qrow, float sl2, char* lds, int tid, int jlo, int NT) {
  Kh += (long)jlo * KVBLK * LDK; Vh += (long)jlo * KVBLK * LDK; qrow -= jlo * KVBLK;
  const int lane = tid & 63, r32 = lane & 31, hi = lane >> 5;
  char* V_lds = lds; char* K_lds = lds + 2 * SHM_V;
  float l_reg = 0; bf16x8 qr[4];
#pragma unroll
  for (int d = 0; d < 4; ++d) o[d] = f32x16{};
#pragma unroll
  for (int d0 = 0; d0 < 4; ++d0) qr[d0] = *reinterpret_cast<const bf16x8*>(Qw + d0 * 16);
  const int sr = tid >> 4, sc = (tid & 15) * 8, vst0 = v_st(sr, sc), vst1 = v_st(32 + sr, sc);
  const int kr = tid >> 3, kc = (tid & 7) * 8, kst = AT_KSWZ(kr, kc * 2);
  const int vb0 = (int)(uintptr_t)(__attribute__((address_space(3))) char*)V_lds + v_rd_base(lane);
  struct { bf16x8 vs0, vs1, ks0; } sr_[2];
#define AT_SLOAD(i, k0) do { sr_[i].vs0 = *reinterpret_cast<const bf16x8*>(&Vh[(long)((k0) + sr) * LDK + sc]); sr_[i].vs1 = *reinterpret_cast<const bf16x8*>(&Vh[(long)((k0) + 32 + sr) * LDK + sc]); \
    sr_[i].ks0 = *reinterpret_cast<const bf16x8*>(&Kh[(long)((k0) + kr) * LDK + kc]); } while (0)
#define AT_SWRITE(b, i) do { *(bf16x8*)(V_lds + (b) * SHM_V + vst0) = sr_[i].vs0; *(bf16x8*)(V_lds + (b) * SHM_V + vst1) = sr_[i].vs1; \
    *(bf16x8*)(K_lds + (b) * SHM_K + kst) = sr_[i].ks0; } while (0)
#define AT_SWAIT() asm volatile("s_waitcnt vmcnt(3)" ::: "memory")
  f32x16 pA0, pA1, pB0, pB1; bf16x8 pa0, pa1, pa2, pa3;
  float base = (float)(qrow - 4 * hi);
  constexpr int SE = 0, SO = 1;
  AT_SLOAD(SE, 0); asm volatile("s_waitcnt vmcnt(0)" ::: "memory"); AT_SWRITE(0, SE); __syncthreads();
  qkt(pA0, pA1, K_lds, qr, r32, hi); partialSM(pA0, pA1, base, sl2); base -= 64.f;
  AT_SLOAD(SO, KVBLK); AT_SLOAD(SE, 2 * KVBLK);
  AT_SWAIT(); AT_SWRITE(1, SO); __syncthreads();
#define AT_PVSM(VB, P0, P1) do { pv_psm(o, VB, pa0, pa1, pa2, pa3, P0, P1, sl2, -sl2 * base); base -= 64.f; } while (0)
  for (int j = 1; j + 1 < NT; j += 2) {
    AT_SBAR(); qkt_fin(pB0, pB1, K_lds + SHM_K, qr, r32, hi, pA0, pA1, l_reg, pa0, pa1, pa2, pa3); AT_SBAR();
    AT_SLOAD(SO, (j + 2) * KVBLK); AT_SBAR();
    AT_PVSM(vb0, pB0, pB1); AT_SBAR();
    __syncthreads(); AT_SWAIT(); AT_SWRITE(0, SE);
    __syncthreads();
    AT_SBAR(); qkt_fin(pA0, pA1, K_lds, qr, r32, hi, pB0, pB1, l_reg, pa0, pa1, pa2, pa3); AT_SBAR();
    if (j + 3 < NT) AT_SLOAD(SE, (j + 3) * KVBLK); AT_SBAR();
    AT_PVSM(vb0 + (int)SHM_V, pA0, pA1); AT_SBAR();
    __syncthreads(); AT_SWAIT(); AT_SWRITE(1, SO);
    __syncthreads();
  }
#undef AT_PVSM
  AT_SBAR(); qkt(pB0, pB1, K_lds + SHM_K, qr, r32, hi);
  finishSM(pA0, pA1, l_reg, pa0, pa1, pa2, pa3); AT_SBAR();
  pv_d0(o, vb0, pa0, pa1, pa2, pa3); partialSM(pB0, pB1, base, sl2);
  __syncthreads();
  finishSM(pB0, pB1, l_reg, pa0, pa1, pa2, pa3); AT_SBAR();
  pv_d0(o, vb0 + (int)SHM_V, pa0, pa1, pa2, pa3);
  l_out = l_reg;
  asm volatile("s_waitcnt vmcnt(0)" ::: "memory");
  __syncthreads();
#undef AT_SLOAD
#undef AT_SWRITE
#undef AT_SWAIT
}
}

namespace sd {
using bf16x8 = __attribute__((ext_vector_type(8))) short;
using s16x4  = __attribute__((ext_vector_type(4))) short;
using f32x16 = __attribute__((ext_vector_type(16))) float;
using f32x4  = __attribute__((ext_vector_type(4))) float;
using u32x4  = __attribute__((ext_vector_type(4))) unsigned;
using u32x2  = __attribute__((ext_vector_type(2))) unsigned;
constexpr int RSX = 1088, RSB1 = 192, RSBC = 144, RSY = 1040;
constexpr int O_X = 0, O_B1 = 69632, O_W1 = O_B1 + 2 * 64 * RSB1;
constexpr int O_B3 = 69632, O_C3 = O_B3 + 2 * 64 * RSBC, O_SC = O_C3 + 2 * 64 * RSBC, O_EF = O_SC + 8 * 64 * 16;
constexpr float LOG2E = 1.4426950408889634f;
#define SD_LAS __attribute__((address_space(3)))
template <int OFF> __device__ __forceinline__ s16x4 trr(int addr) { s16x4 r; asm volatile("ds_read_b64_tr_b16 %0, %1 offset:%2" : "=&v"(r) : "v"(addr), "i"(OFF) : "memory"); return r; }
#define SD_PK(L, H) __builtin_shufflevector(L, H, 0, 1, 2, 3, 4, 5, 6, 7)
#define SD_LWAIT() do { asm volatile("s_waitcnt lgkmcnt(0)" ::: "memory"); __builtin_amdgcn_sched_barrier(0); } while (0)
__device__ __forceinline__ unsigned cvtpk(float lo, float hi) { unsigned r; asm volatile("v_cvt_pk_bf16_f32 %0, %1, %2" : "=v"(r) : "v"(lo), "v"(hi)); return r; }
__device__ __forceinline__ bf16x8 scale8(bf16x8 f, f32x4 wa, f32x4 wb) {
    const u32x4 u = *reinterpret_cast<const u32x4*>(&f); u32x4 o;
    o.x = cvtpk(__uint_as_float(u.x << 16) * wa[0], __uint_as_float(u.x & 0xffff0000u) * wa[1]);
    o.y = cvtpk(__uint_as_float(u.y << 16) * wa[2], __uint_as_float(u.y & 0xffff0000u) * wa[3]);
    o.z = cvtpk(__uint_as_float(u.z << 16) * wb[0], __uint_as_float(u.z & 0xffff0000u) * wb[1]);
    o.w = cvtpk(__uint_as_float(u.w << 16) * wb[2], __uint_as_float(u.w & 0xffff0000u) * wb[3]);
    return *reinterpret_cast<const bf16x8*>(&o);
}
__device__ __forceinline__ float wave_incl_scan(float v, int lane) {
#pragma unroll
    for (int o = 1; o < 64; o <<= 1) { const float t = shidx(v, lane - o); if (lane >= o) v += t; }
    return v;
}
__device__ __forceinline__ int tr_lane_base(int lane, int RS, int khi) { const int g = lane >> 4, i = lane & 15, q = i >> 2, pp = i & 3; return ((g >> 1) * khi + q) * RS + (16 * (g & 1) + 4 * pp) * 2; }

__device__ __forceinline__ void conv_task(const unsigned short* XBC, const float* cw, const float* cb, size_t tok0, int s0, int rg, int ch, char* dst, int rs) {
    float w[5][8], bias[8];
#pragma unroll
    for (int k = 0; k < 5; ++k) { const f32x4 a = *(const f32x4*)(cw + k * 768 + ch), b = *(const f32x4*)(cw + k * 768 + ch + 4);
        w[k][0] = a[0]; w[k][1] = a[1]; w[k][2] = a[2]; w[k][3] = a[3]; w[k][4] = b[0]; w[k][5] = b[1]; w[k][6] = b[2]; w[k][7] = b[3]; }
    { const f32x4 a = *(const f32x4*)(cb + ch), b = *(const f32x4*)(cb + ch + 4); bias[0] = a[0]; bias[1] = a[1]; bias[2] = a[2]; bias[3] = a[3]; bias[4] = b[0]; bias[5] = b[1]; bias[6] = b[2]; bias[7] = b[3]; }
    u32x4 raw[12];
#pragma unroll
    for (int i = 0; i < 12; ++i) { const int sq = s0 + rg * 8 + i - 2; raw[i] = (u32x4){0u, 0u, 0u, 0u};
        if (sq >= 0 && sq < SEQ) raw[i] = *(const u32x4*)(XBC + (tok0 + rg * 8 + i - 2) * 768 + ch); }
    float xr[12][8];
#pragma unroll
    for (int i = 0; i < 12; ++i) { xr[i][0] = __uint_as_float(raw[i].x << 16); xr[i][1] = __uint_as_float(raw[i].x & 0xffff0000u); xr[i][2] = __uint_as_float(raw[i].y << 16); xr[i][3] = __uint_as_float(raw[i].y & 0xffff0000u);
        xr[i][4] = __uint_as_float(raw[i].z << 16); xr[i][5] = __uint_as_float(raw[i].z & 0xffff0000u); xr[i][6] = __uint_as_float(raw[i].w << 16); xr[i][7] = __uint_as_float(raw[i].w & 0xffff0000u); }
#pragma unroll
    for (int r = 0; r < 8; ++r) {
        float a[8];
#pragma unroll
        for (int j = 0; j < 8; ++j) { float v = bias[j];
#pragma unroll
            for (int k = 0; k < 5; ++k) v = fmaf(w[k][j], xr[r + k][j], v);
            a[j] = v * __builtin_amdgcn_rcpf(1.f + __expf(-v)); }
        u32x4 o; o.x = cvtpk(a[0], a[1]); o.y = cvtpk(a[2], a[3]); o.z = cvtpk(a[4], a[5]); o.w = cvtpk(a[6], a[7]);
        *(u32x4*)(dst + r * rs) = o;
    }
}
template <int RSBx, bool WITH_C>
__device__ __forceinline__ void load_images(const unsigned short* XBC, const float* cw, const float* cb, size_t tok0, char* lds, int obase_b, int obase_c, int tid) {
    const int s0 = (int)(tok0 & (SEQ - 1));
    { const int rg = tid >> 6, c16 = tid & 63; conv_task(XBC, cw, cb, tok0, s0, rg, c16 * 8, lds + O_X + rg * 8 * RSX + c16 * 16, RSX); }
    if (tid < (WITH_C ? 256 : 128)) {
        const int c16 = tid & (WITH_C ? 31 : 15), rg = tid >> (WITH_C ? 5 : 4), isc = c16 >> 4, g = (c16 >> 3) & 1, wi = c16 & 7;
        conv_task(XBC, cw, cb, tok0, s0, rg, 512 + c16 * 8, lds + (isc ? obase_c : obase_b) + g * 64 * RSBx + rg * 8 * RSBx + wi * 16, RSBx);
    }
}

__device__ __forceinline__ void s1_unit(const unsigned short* XC, const float* cw, const float* cb, const float* dt, const float* a_log, unsigned short* Sloc, float* TOT, int unit, char* lds) {
    int tid = threadIdx.x; asm volatile("" : "+v"(tid));
    const int lane = tid & 63, h = __builtin_amdgcn_readfirstlane(tid >> 6), g = h >> 2, r32 = lane & 31, hi = lane >> 5;
    const size_t tok0 = (size_t)(unit >> 5) * SEQ + (unit & 31) * 64;
    const float dtf = dt[(tok0 + lane) * 16 + h], dtb = dt[(tok0 + lane) * 16 + 8 + h];
    load_images<RSB1, false>(XC, cw, cb, tok0, lds, O_B1, 0, tid);
    {
        const float af = dtf * -expf(a_log[h]), ab = dtb * -expf(a_log[8 + h]);
        const float cumf = wave_incl_scan(af, lane), cumb = wave_incl_scan(ab, lane);
        const float totf = shidx(cumf, 63), totb = shidx(cumb, 63);
        float* wsc = (float*)(lds + O_W1) + h * 128;
        wsc[lane] = expf(totf - cumf) * dtf; wsc[64 + lane] = expf(cumb - ab) * dtb;
        if (lane == 0) { TOT[(unit * 8 + h) * 2] = totf; TOT[(unit * 8 + h) * 2 + 1] = totb; }
    }
    __syncthreads();
    const int ldsb = (int)(uintptr_t)(SD_LAS char*)lds;
    const int xb = ldsb + O_X + tr_lane_base(lane, RSX, 8) + h * 128;
    const int bb = ldsb + O_B1 + g * 64 * RSB1 + tr_lane_base(lane, RSB1, 8);
    const float* wl = (const float*)(lds + O_W1) + h * 128 + 8 * hi;
    f32x16 acc[2][2][2];
#pragma unroll
    for (int d = 0; d < 2; ++d)
#pragma unroll
        for (int a = 0; a < 2; ++a)
#pragma unroll
            for (int b = 0; b < 2; ++b) acc[d][a][b] = f32x16{};
#define SD_S1_STEP(KS) do { \
        const s16x4 x0l = trr<(KS) * 16 * RSX>(xb), x0h = trr<(KS) * 16 * RSX + 4 * RSX>(xb), x1l = trr<(KS) * 16 * RSX + 64>(xb), x1h = trr<(KS) * 16 * RSX + 4 * RSX + 64>(xb); \
        const s16x4 b0l = trr<(KS) * 16 * RSB1>(bb), b0h = trr<(KS) * 16 * RSB1 + 4 * RSB1>(bb), b1l = trr<(KS) * 16 * RSB1 + 64>(bb), b1h = trr<(KS) * 16 * RSB1 + 4 * RSB1 + 64>(bb); \
        const f32x4 wfa = *(const f32x4*)(wl + (KS) * 16), wfb = *(const f32x4*)(wl + (KS) * 16 + 4), wba = *(const f32x4*)(wl + 64 + (KS) * 16), wbb = *(const f32x4*)(wl + 64 + (KS) * 16 + 4); \
        SD_LWAIT(); \
        const bf16x8 X0 = SD_PK(x0l, x0h), X1 = SD_PK(x1l, x1h), B0 = SD_PK(b0l, b0h), B1 = SD_PK(b1l, b1h); \
        const bf16x8 A0f = scale8(B0, wfa, wfb), A1f = scale8(B1, wfa, wfb), A0b = scale8(B0, wba, wbb), A1b = scale8(B1, wba, wbb); \
        acc[0][0][0] = __builtin_amdgcn_mfma_f32_32x32x16_bf16(A0f, X0, acc[0][0][0], 0, 0, 0); acc[0][0][1] = __builtin_amdgcn_mfma_f32_32x32x16_bf16(A0f, X1, acc[0][0][1], 0, 0, 0); \
        acc[0][1][0] = __builtin_amdgcn_mfma_f32_32x32x16_bf16(A1f, X0, acc[0][1][0], 0, 0, 0); acc[0][1][1] = __builtin_amdgcn_mfma_f32_32x32x16_bf16(A1f, X1, acc[0][1][1], 0, 0, 0); \
        acc[1][0][0] = __builtin_amdgcn_mfma_f32_32x32x16_bf16(A0b, X0, acc[1][0][0], 0, 0, 0); acc[1][0][1] = __builtin_amdgcn_mfma_f32_32x32x16_bf16(A0b, X1, acc[1][0][1], 0, 0, 0); \
        acc[1][1][0] = __builtin_amdgcn_mfma_f32_32x32x16_bf16(A1b, X0, acc[1][1][0], 0, 0, 0); acc[1][1][1] = __builtin_amdgcn_mfma_f32_32x32x16_bf16(A1b, X1, acc[1][1][1], 0, 0, 0); \
    } while (0)
    SD_S1_STEP(0); SD_S1_STEP(1); SD_S1_STEP(2); SD_S1_STEP(3);
#undef SD_S1_STEP
#pragma unroll
    for (int d = 0; d < 2; ++d) {
        unsigned short* dst = Sloc + ((size_t)(unit * 8 + h) * 2 + d) * 4096;
#pragma unroll
        for (int nt = 0; nt < 2; ++nt)
#pragma unroll
            for (int pt = 0; pt < 2; ++pt)
#pragma unroll
                for (int q4 = 0; q4 < 4; ++q4) { u32x2 o; o.x = cvtpk(acc[d][nt][pt][4 * q4], acc[d][nt][pt][4 * q4 + 1]); o.y = cvtpk(acc[d][nt][pt][4 * q4 + 2], acc[d][nt][pt][4 * q4 + 3]);
                    *(u32x2*)(dst + (32 * pt + r32) * 64 + 32 * nt + 8 * q4 + 4 * hi) = o; }
    }
    __syncthreads();
}

__device__ __forceinline__ void s2_scan(unsigned short* Sloc, const float* TOT, int gtid, int gthreads) {
    for (int id = gtid; id < NB * 8 * 2 * 512; id += gthreads) {
        const int e8 = id & 511, dir = (id >> 9) & 1, h = (id >> 10) & 7, b = id >> 13;
        const int c0 = dir ? 31 : 0;
        const long cstep = (long)(dir ? -1 : 1) * 8 * 2 * 4096;
        unsigned short* ptr = Sloc + ((size_t)((b * 32 + c0) * 8 + h) * 2 + dir) * 4096 + e8 * 8;
        const float* tp = TOT + ((b * 32 + c0) * 8 + h) * 2 + dir; const int tstep = (dir ? -1 : 1) * 16;
        float carry[8];
#pragma unroll
        for (int j = 0; j < 8; ++j) carry[j] = 0.f;
#pragma unroll 1
        for (int half = 0; half < 2; ++half) {
            u32x4 v[16]; float dec[16];
            { unsigned short* lp = ptr; const float* lt = tp;
#pragma unroll
              for (int cc = 0; cc < 16; ++cc) { v[cc] = *(const u32x4*)lp; dec[cc] = *lt; lp += cstep; lt += tstep; } }
#pragma unroll
            for (int cc = 0; cc < 16; ++cc) {
                const float dc = expf(dec[cc]);
                u32x4 o; o.x = cvtpk(carry[0], carry[1]); o.y = cvtpk(carry[2], carry[3]); o.z = cvtpk(carry[4], carry[5]); o.w = cvtpk(carry[6], carry[7]);
                *(u32x4*)ptr = o;
                const u32x4 w = v[cc];
                carry[0] = fmaf(carry[0], dc, __uint_as_float(w.x << 16)); carry[1] = fmaf(carry[1], dc, __uint_as_float(w.x & 0xffff0000u));
                carry[2] = fmaf(carry[2], dc, __uint_as_float(w.y << 16)); carry[3] = fmaf(carry[3], dc, __uint_as_float(w.y & 0xffff0000u));
                carry[4] = fmaf(carry[4], dc, __uint_as_float(w.z << 16)); carry[5] = fmaf(carry[5], dc, __uint_as_float(w.z & 0xffff0000u));
                carry[6] = fmaf(carry[6], dc, __uint_as_float(w.w << 16)); carry[7] = fmaf(carry[7], dc, __uint_as_float(w.w & 0xffff0000u));
                ptr += cstep; tp += tstep;
            }
        }
    }
}

__device__ __forceinline__ void s3_unit(const unsigned short* XC, const float* cw, const float* cb, const float* dt, const float* a_log, const float* d_skip, const unsigned short* Sin, const unsigned short* Zb,
                                        const float* ssd_norm, unsigned short* MIX, int unit, char* lds) {
    int tid = threadIdx.x; asm volatile("" : "+v"(tid));
    const int lane = tid & 63, h = __builtin_amdgcn_readfirstlane(tid >> 6), g = h >> 2, r32 = lane & 31, hi = lane >> 5;
    const size_t tok0 = (size_t)(unit >> 5) * SEQ + (unit & 31) * 64;
    const float dtf = dt[(tok0 + lane) * 16 + h], dtb = dt[(tok0 + lane) * 16 + 8 + h];
    bf16x8 sf[2][2][4];
    {
        const unsigned short* sp = Sin + (size_t)(unit * 8 + h) * 2 * 4096 + r32 * 64 + 8 * hi;
#pragma unroll
        for (int d = 0; d < 2; ++d)
#pragma unroll
            for (int pt = 0; pt < 2; ++pt)
#pragma unroll
                for (int ks = 0; ks < 4; ++ks) sf[d][pt][ks] = *(const bf16x8*)(sp + d * 4096 + pt * 32 * 64 + ks * 16);
    }
    load_images<RSBC, true>(XC, cw, cb, tok0, lds, O_B3, O_C3, tid);
    {
        const float af = dtf * -expf(a_log[h]), ab = dtb * -expf(a_log[8 + h]);
        const float cumf = wave_incl_scan(af, lane), cumb = wave_incl_scan(ab, lane);
        const float totb = shidx(cumb, 63), eb = cumb - ab;
        *(f32x4*)(lds + O_SC + (h * 64 + lane) * 16) = (f32x4){cumf * LOG2E, dtf, eb * LOG2E, dtb};
        float* ef = (float*)(lds + O_EF) + h * 128;
        ef[lane] = expf(cumf); ef[64 + lane] = expf(totb - eb);
    }
    __syncthreads();
    const int ldsb = (int)(uintptr_t)(SD_LAS char*)lds;
    const int xb = ldsb + O_X + tr_lane_base(lane, RSX, 4) + h * 128;
    const char* bimg = lds + O_B3 + g * 64 * RSBC + r32 * RSBC + 16 * hi;
    const char* cimg = lds + O_C3 + g * 64 * RSBC + r32 * RSBC + 16 * hi;
    const char* scb = lds + O_SC + (h * 64 + 4 * hi) * 16;
    const float Dh = d_skip[h];
    f32x16 Y[2][2];
#pragma unroll
    for (int a = 0; a < 2; ++a)
#pragma unroll
        for (int b = 0; b < 2; ++b) Y[a][b] = f32x16{};
#define SD_TILE(LT, ST) do { \
        f32x16 G = f32x16{}; \
        _Pragma("unroll") for (int ks = 0; ks < 4; ++ks) { const bf16x8 Af = *(const bf16x8*)(bimg + (ST) * 32 * RSBC + ks * 32), Bf = *(const bf16x8*)(cimg + (LT) * 32 * RSBC + ks * 32); \
            G = __builtin_amdgcn_mfma_f32_32x32x16_bf16(Af, Bf, G, 0, 0, 0); } \
        const f32x4 scl = *(const f32x4*)(lds + O_SC + (h * 64 + (LT) * 32 + r32) * 16); \
        _Pragma("unroll") for (int r = 0; r < 16; ++r) { \
            const f32x4 sc = *(const f32x4*)(scb + ((ST) * 32 + (r & 3) + 8 * (r >> 2)) * 16); \
            const int sl = (r & 3) + 8 * (r >> 2) + 4 * hi; \
            float f; \
            if ((ST) < (LT)) f = __builtin_amdgcn_exp2f(scl[0] - sc[0]) * sc[1]; \
            else if ((ST) > (LT)) f = __builtin_amdgcn_exp2f(sc[2] - scl[2]) * sc[3]; \
            else { const float ff = __builtin_amdgcn_exp2f(scl[0] - sc[0]) * sc[1], fb = __builtin_amdgcn_exp2f(sc[2] - scl[2]) * sc[3]; f = (sl <= r32 ? ff : 0.f) + (sl >= r32 ? fb : 0.f); } \
            G[r] = G[r] * f; if ((ST) == (LT)) G[r] += (sl == r32 ? Dh : 0.f); } \
        u32x4 w0, w1; w0.x = cvtpk(G[0], G[1]); w0.y = cvtpk(G[2], G[3]); w0.z = cvtpk(G[4], G[5]); w0.w = cvtpk(G[6], G[7]); \
        w1.x = cvtpk(G[8], G[9]); w1.y = cvtpk(G[10], G[11]); w1.z = cvtpk(G[12], G[13]); w1.w = cvtpk(G[14], G[15]); \
        const bf16x8 W0 = *reinterpret_cast<const bf16x8*>(&w0), W1 = *reinterpret_cast<const bf16x8*>(&w1); \
        const s16x4 a00l = trr<(ST) * 32 * RSX>(xb), a00h = trr<(ST) * 32 * RSX + 8 * RSX>(xb), a01l = trr<(ST) * 32 * RSX + 16 * RSX>(xb), a01h = trr<(ST) * 32 * RSX + 24 * RSX>(xb); \
        const s16x4 a10l = trr<(ST) * 32 * RSX + 64>(xb), a10h = trr<(ST) * 32 * RSX + 8 * RSX + 64>(xb), a11l = trr<(ST) * 32 * RSX + 16 * RSX + 64>(xb), a11h = trr<(ST) * 32 * RSX + 24 * RSX + 64>(xb); \
        SD_LWAIT(); \
        Y[LT][0] = __builtin_amdgcn_mfma_f32_32x32x16_bf16(SD_PK(a00l, a00h), W0, Y[LT][0], 0, 0, 0); Y[LT][0] = __builtin_amdgcn_mfma_f32_32x32x16_bf16(SD_PK(a01l, a01h), W1, Y[LT][0], 0, 0, 0); \
        Y[LT][1] = __builtin_amdgcn_mfma_f32_32x32x16_bf16(SD_PK(a10l, a10h), W0, Y[LT][1], 0, 0, 0); Y[LT][1] = __builtin_amdgcn_mfma_f32_32x32x16_bf16(SD_PK(a11l, a11h), W1, Y[LT][1], 0, 0, 0); \
    } while (0)
    SD_TILE(0, 0); SD_TILE(0, 1); SD_TILE(1, 0); SD_TILE(1, 1);
#undef SD_TILE
    {
        const float* ef = (const float*)(lds + O_EF) + h * 128;
#pragma unroll
        for (int lt = 0; lt < 2; ++lt) {
            bf16x8 Cf[4];
#pragma unroll
            for (int ks = 0; ks < 4; ++ks) Cf[ks] = *(const bf16x8*)(cimg + lt * 32 * RSBC + ks * 32);
#pragma unroll
            for (int d = 0; d < 2; ++d) {
                const float e = ef[d * 64 + lt * 32 + r32];
#pragma unroll
                for (int pt = 0; pt < 2; ++pt) {
                    f32x16 Tt = f32x16{};
#pragma unroll
                    for (int ks = 0; ks < 4; ++ks) Tt = __builtin_amdgcn_mfma_f32_32x32x16_bf16(sf[d][pt][ks], Cf[ks], Tt, 0, 0, 0);
#pragma unroll
                    for (int r = 0; r < 16; ++r) Y[lt][pt][r] = fmaf(Tt[r], e, Y[lt][pt][r]);
                }
            }
        }
    }
    __syncthreads();
#pragma unroll
    for (int lt = 0; lt < 2; ++lt)
#pragma unroll
        for (int pt = 0; pt < 2; ++pt)
#pragma unroll
            for (int q4 = 0; q4 < 4; ++q4) { u32x2 o; o.x = cvtpk(Y[lt][pt][4 * q4], Y[lt][pt][4 * q4 + 1]); o.y = cvtpk(Y[lt][pt][4 * q4 + 2], Y[lt][pt][4 * q4 + 3]);
                *(u32x2*)(lds + (lt * 32 + r32) * RSY + (h * 64 + pt * 32 + q4 * 8 + 4 * hi) * 2) = o; }
    __syncthreads();
    {
        u32x4 zv[8], yv[8];
#pragma unroll
        for (int i = 0; i < 8; ++i) { const int l = h * 8 + i; zv[i] = *(const u32x4*)(Zb + (tok0 + l) * 512 + lane * 8); yv[i] = *(const u32x4*)(lds + l * RSY + lane * 16); }
        const f32x4 n0 = *(const f32x4*)(ssd_norm + lane * 8), n1 = *(const f32x4*)(ssd_norm + lane * 8 + 4);
#pragma unroll
        for (int i = 0; i < 8; ++i) {
            const int l = h * 8 + i;
            float y[8], z[8];
            y[0] = __uint_as_float(yv[i].x << 16); y[1] = __uint_as_float(yv[i].x & 0xffff0000u); y[2] = __uint_as_float(yv[i].y << 16); y[3] = __uint_as_float(yv[i].y & 0xffff0000u);
            y[4] = __uint_as_float(yv[i].z << 16); y[5] = __uint_as_float(yv[i].z & 0xffff0000u); y[6] = __uint_as_float(yv[i].w << 16); y[7] = __uint_as_float(yv[i].w & 0xffff0000u);
            z[0] = __uint_as_float(zv[i].x << 16); z[1] = __uint_as_float(zv[i].x & 0xffff0000u); z[2] = __uint_as_float(zv[i].y << 16); z[3] = __uint_as_float(zv[i].y & 0xffff0000u);
            z[4] = __uint_as_float(zv[i].z << 16); z[5] = __uint_as_float(zv[i].z & 0xffff0000u); z[6] = __uint_as_float(zv[i].w << 16); z[7] = __uint_as_float(zv[i].w & 0xffff0000u);
            float ss = 0.f;
#pragma unroll
            for (int j = 0; j < 8; ++j) { y[j] = y[j] * (z[j] * __builtin_amdgcn_rcpf(1.f + __expf(-z[j]))); ss += y[j] * y[j]; }
#pragma unroll
            for (int o = 32; o > 0; o >>= 1) ss += shx(ss, o, lane);
            const float rs = rsqrtf(ss * (1.f / 512.f) + EPS);
            u32x4 o; o.x = cvtpk(y[0] * rs * n0[0], y[1] * rs * n0[1]); o.y = cvtpk(y[2] * rs * n0[2], y[3] * rs * n0[3]);
            o.z = cvtpk(y[4] * rs * n1[0], y[5] * rs * n1[1]); o.w = cvtpk(y[6] * rs * n1[2], y[7] * rs * n1[3]);
            *(u32x4*)(MIX + (tok0 + l) * D + 512 + lane * 8) = o;
        }
    }
    __syncthreads();
}
}

#define XB_TMO      128
#define XB_XCNT(j)  (256  + 64 * (j))
#define XB_XSUB(j)  (1280 + 64 * (j))
#define XB_XGEN(j)  (2304 + 64 * (j))
#define XB_TOP      3328
#define XB_TOPGEN   3392
#define XCD_BAR_WORDS 3456
#define XB_SPIN_CAP (1u << 22)
__device__ __forceinline__ unsigned xb_ld(unsigned* p)              { return __hip_atomic_load(p, __ATOMIC_RELAXED, __HIP_MEMORY_SCOPE_AGENT); }
__device__ __forceinline__ unsigned xb_add(unsigned* p, unsigned v) { return __hip_atomic_fetch_add(p, v, __ATOMIC_RELAXED, __HIP_MEMORY_SCOPE_AGENT); }
__device__ __forceinline__ unsigned xb_xcc_id() { return (unsigned)__builtin_amdgcn_s_getreg((3 << 11) | 20) & 0xFu; }
#define XB_SPIN(cond, bar) do { unsigned _sp = 0; while (cond) { __builtin_amdgcn_s_sleep(1); \
    if ((++_sp & 255u) == 0u) { if (xb_ld(&(bar)[XB_TMO])) break; if (_sp > XB_SPIN_CAP) { atomicAdd(&(bar)[XB_TMO], 1u); break; } } } } while (0)
struct XcdBarrier { unsigned* bar; unsigned x; volatile MK_LAS unsigned* st; };
__device__ __forceinline__ XcdBarrier xcd_barrier_post(unsigned* bar, volatile MK_LAS unsigned* st) {
    XcdBarrier b; b.bar = bar; b.x = xb_xcc_id(); b.st = st;
    if (threadIdx.x == 0) (void)xb_add(&bar[XB_XCNT(b.x)], 1u);
    return b;
}
__device__ __forceinline__ void xcd_barrier_complete(unsigned* bar, unsigned x, unsigned& nloc, unsigned& nx) {
    const unsigned G = gridDim.x * gridDim.y * gridDim.z;
    unsigned sum, cnt, mine, sp = 0u;
    for (;;) {
        sum = 0u; cnt = 0u; mine = 0u;
#pragma unroll
        for (unsigned j = 0; j < 16; ++j) { const unsigned c = xb_ld(&bar[XB_XCNT(j)]); sum += c; cnt += (c > 0u) ? 1u : 0u; mine = (j == x) ? c : mine; }
        if (sum == G) break;
        __builtin_amdgcn_s_sleep(1);
        if ((++sp & 255u) == 0u) { if (xb_ld(&bar[XB_TMO])) break; if (sp > XB_SPIN_CAP) { atomicAdd(&bar[XB_TMO], 1u); break; } }
    }
    nloc = mine > 0u ? mine : 1u; nx = cnt > 0u ? cnt : 1u;
}
__device__ __forceinline__ void xcd_barrier(const XcdBarrier& b) {
    asm volatile("s_waitcnt vmcnt(0)" ::: "memory");
    __syncthreads();
    if (threadIdx.x == 0) {
        unsigned* bar = b.bar;
        __builtin_amdgcn_s_waitcnt(0);
        unsigned nloc = b.st[0], nx = b.st[1];
        if (nloc == 0u) { xcd_barrier_complete(bar, b.x, nloc, nx); b.st[0] = nloc; b.st[1] = nx; }
        const unsigned old = xb_add(&bar[XB_XSUB(b.x)], 1u);
        const unsigned gen = old / nloc;
        if (old + 1u == (gen + 1u) * nloc) {
            __builtin_amdgcn_fence(__ATOMIC_RELEASE, "agent");
            asm volatile("s_waitcnt vmcnt(0)" ::: "memory");
            const unsigned og = xb_add(&bar[XB_TOP], 1u);
            const unsigned tg = og / nx;
            if (og + 1u == (tg + 1u) * nx) xb_add(&bar[XB_TOPGEN], 1u);
            else XB_SPIN(xb_ld(&bar[XB_TOPGEN]) == tg, bar);
            __builtin_amdgcn_fence(__ATOMIC_ACQUIRE, "agent");
            xb_add(&bar[XB_XGEN(b.x)], 1u);
            asm volatile("s_waitcnt vmcnt(0)" ::: "memory");
        } else {
            XB_SPIN(xb_ld(&bar[XB_XGEN(b.x)]) == gen, bar);
            __builtin_amdgcn_fence(__ATOMIC_ACQUIRE, "agent");
            asm volatile("s_waitcnt vmcnt(0)" ::: "memory");
        }
    }
    __syncthreads();
}

typedef unsigned short bf16;
using mk::bf2f; using mk::f2bf; using mk::cvt_pk_bf16; using mk::f32x4; using mk::u32x4; using mk::u32x2; using mk::Unit;

constexpr size_t al256(size_t v) { return (v + 255) & ~(size_t)255; }
constexpr size_t OFF_ACT = 0;
constexpr size_t OFF_MIX = OFF_ACT + al256((size_t)T * D * 2);
constexpr size_t OFF_BIG = OFF_MIX + al256((size_t)T * D * 2);
constexpr size_t OFF_WinT = OFF_BIG + al256((size_t)192 << 20);
constexpr size_t OFF_WoutT = OFF_WinT + al256((size_t)3072 * D * 2);
constexpr size_t OFF_WfT = OFF_WoutT + al256((size_t)D * D * 2);
constexpr size_t OFF_W13T = OFF_WfT + al256((size_t)D * D * 2);
constexpr size_t OFF_W2T = OFF_W13T + al256((size_t)64 * 512 * D * 2);
constexpr size_t OFF_DcT = OFF_W2T + al256((size_t)64 * D * HID * 2);
constexpr size_t OFF_CS = OFF_DcT + al256((size_t)4 * 512 * 256 * 2);
constexpr size_t OFF_rstd0 = OFF_CS + al256((size_t)2048 * 4096 * 2);
constexpr size_t OFF_rstd2 = OFF_rstd0 + al256((size_t)T * 4);
constexpr size_t OFF_dt = OFF_rstd2 + al256((size_t)T * 4);
constexpr size_t OFF_qkn = OFF_dt + al256((size_t)T * 16 * 4);
constexpr size_t OFF_WR = OFF_qkn + al256(512);
constexpr size_t OFF_LG = OFF_WR + al256((size_t)2 * 1024 * 36 * 4);
constexpr size_t OFF_cnt = OFF_LG + al256((size_t)T * 36 * 4);
constexpr size_t OFF_bar = OFF_cnt + al256(8192 + 256);
constexpr size_t OFF_list = OFF_bar + al256((size_t)XCD_BAR_WORDS * 4);
constexpr size_t OFF_TOT = OFF_list + al256((size_t)32 * CAP * 16);
constexpr size_t OFF_ccnt = OFF_TOT + al256((size_t)NB * 32 * 8 * 2 * 4);
constexpr size_t OFF_mids = OFF_ccnt + al256((size_t)256 * 64);
constexpr size_t WS_END = OFF_mids + al256((size_t)6 * 65536);
struct Params {
    const float *x, *norm_mix, *norm_ffn, *w_in, *q_norm, *k_norm, *lq1, *lk1, *lq2, *lk2, *subln, *conv_w, *conv_b,
        *dt_bias, *a_log, *d_skip, *ssd_norm, *w_out, *w_f, *rg_w, *rg_b, *re_w, *re_b, *w1, *w3, *w2;
    float* out;
    unsigned char* ws;
    __device__ __forceinline__ bf16* ACT() const { return (bf16*)(ws + OFF_ACT); }
    __device__ __forceinline__ bf16* MIX() const { return (bf16*)(ws + OFF_MIX); }
    __device__ __forceinline__ bf16* WinT() const { return (bf16*)(ws + OFF_WinT); }
    __device__ __forceinline__ bf16* WoutT() const { return (bf16*)(ws + OFF_WoutT); }
    __device__ __forceinline__ bf16* WfT() const { return (bf16*)(ws + OFF_WfT); }
    __device__ __forceinline__ bf16* W13T() const { return (bf16*)(ws + OFF_W13T); }
    __device__ __forceinline__ bf16* W2T() const { return (bf16*)(ws + OFF_W2T); }
    __device__ __forceinline__ bf16* DcT() const { return (bf16*)(ws + OFF_DcT); }
    __device__ __forceinline__ bf16* CS() const { return (bf16*)(ws + OFF_CS); }
    __device__ __forceinline__ float* rstd0() const { return (float*)(ws + OFF_rstd0); }
    __device__ __forceinline__ float* HMID(int k) const { return (float*)(ws + OFF_mids + (size_t)k * 65536); }
    __device__ __forceinline__ float* PMID(int k) const { return (float*)(ws + OFF_mids + (size_t)(3 + k) * 65536); }
    __device__ __forceinline__ bf16* X4(int a) const { return (bf16*)(ws + OFF_MIX + ((size_t)a << 24)); }
    __device__ __forceinline__ float* dt() const { return (float*)(ws + OFF_dt); }
    __device__ __forceinline__ float* qkn() const { return (float*)(ws + OFF_qkn); }
    __device__ __forceinline__ float* WR() const { return (float*)(ws + OFF_WR); }
    __device__ __forceinline__ float* LG() const { return (float*)(ws + OFF_LG); }
    __device__ __forceinline__ int* cnt() const { return (int*)(ws + OFF_cnt); }
    __device__ __forceinline__ unsigned* bar() const { return (unsigned*)(ws + OFF_bar); }
    __device__ __forceinline__ int4* list() const { return (int4*)(ws + OFF_list); }
    __device__ __forceinline__ float* TOT() const { return (float*)(ws + OFF_TOT); }
    __device__ __forceinline__ bf16* Qb() const { return (bf16*)(ws + OFF_BIG + 0); }
    __device__ __forceinline__ bf16* Kb() const { return (bf16*)(ws + OFF_BIG + (size_t)T * 512 * 2); }
    __device__ __forceinline__ bf16* Vb() const { return (bf16*)(ws + OFF_BIG + (size_t)T * 512 * 4); }
    __device__ __forceinline__ bf16* Zb() const { return (bf16*)(ws + OFF_BIG + (size_t)T * 512 * 6); }
    __device__ __forceinline__ bf16* XBC() const { return (bf16*)(ws + OFF_BIG + (size_t)T * 512 * 8); }
    __device__ __forceinline__ bf16* HID2() const { return (bf16*)(ws + OFF_BIG + 0); }
    __device__ __forceinline__ int* tok() const { return (int*)(ws + OFF_BIG + ((size_t)64 << 20)); }
    __device__ __forceinline__ int* ccnt() const { return (int*)(ws + OFF_ccnt); }
    __device__ __forceinline__ bf16* ZT() const { return (bf16*)(ws + OFF_BIG + 0); }
    __device__ __forceinline__ bf16* SLOC() const { return (bf16*)out; }
    __device__ __forceinline__ bf16* XC() const { return (bf16*)((unsigned char*)out + ((size_t)64 << 20)); }
};

__device__ __forceinline__ float silu_f(float v) { return v / (1.f + expf(-v)); }
__device__ __forceinline__ void unpack8(const u32x4 w, float (&f)[8]) {
    f[0] = __uint_as_float(w.x << 16); f[1] = __uint_as_float(w.x & 0xffff0000u); f[2] = __uint_as_float(w.y << 16); f[3] = __uint_as_float(w.y & 0xffff0000u);
    f[4] = __uint_as_float(w.z << 16); f[5] = __uint_as_float(w.z & 0xffff0000u); f[6] = __uint_as_float(w.w << 16); f[7] = __uint_as_float(w.w & 0xffff0000u);
}
__device__ __forceinline__ u32x4 pack8(const float (&f)[8]) { u32x4 o; o.x = cvt_pk_bf16(f[0], f[1]); o.y = cvt_pk_bf16(f[2], f[3]); o.z = cvt_pk_bf16(f[4], f[5]); o.w = cvt_pk_bf16(f[6], f[7]); return o; }

struct TItem { const float* src; const float* kscale; bf16* dst; int ldn, N, K, k0, n0; };
__device__ __forceinline__ void titem_load(const TItem& t, int tid, float4 (&v)[2], float (&sc)[2]) {
#pragma unroll
    for (int i = 0; i < 2; ++i) { const int k = (tid >> 4) + 32 * i, n4 = (tid & 15) * 4;
        v[i] = make_float4(0.f, 0.f, 0.f, 0.f); if (t.n0 + n4 < t.N) v[i] = *(const float4*)(t.src + (size_t)(t.k0 + k) * t.ldn + t.n0 + n4);
        sc[i] = t.kscale ? t.kscale[t.k0 + k] : 1.f; }
}
__device__ __forceinline__ void titem_lds(float* tile, int tid, const float4 (&v)[2], const float (&sc)[2]) {
#pragma unroll
    for (int i = 0; i < 2; ++i) { const int k = (tid >> 4) + 32 * i, n4 = (tid & 15) * 4; float* tp = tile + k * 65 + n4;
        tp[0] = v[i].x * sc[i]; tp[1] = v[i].y * sc[i]; tp[2] = v[i].z * sc[i]; tp[3] = v[i].w * sc[i]; }
}
__device__ __forceinline__ void titem_store(const TItem& t, const float* tile, int tid) {
    const int n = tid >> 3, k8 = (tid & 7) * 8; const float* tp = tile + k8 * 65 + n;
    u32x4 o; o.x = cvt_pk_bf16(tp[0 * 65], tp[1 * 65]); o.y = cvt_pk_bf16(tp[2 * 65], tp[3 * 65]); o.z = cvt_pk_bf16(tp[4 * 65], tp[5 * 65]); o.w = cvt_pk_bf16(tp[6 * 65], tp[7 * 65]);
    *(u32x4*)(t.dst + (size_t)(t.n0 + n) * t.K + t.k0 + k8) = o;
}
constexpr int TI_IN = 16 * 48, TI_O = 256, TI_F = 256, TI_13 = 32 * 128, TI_2 = 32 * 64, TI_SET0 = TI_IN + TI_O + TI_13, TI_SET1 = TI_2 + TI_F + TI_13, TI_SET2 = TI_2;
constexpr int TI_SET1_A = 5000;
template <class P> __device__ __forceinline__ void titem_w13(const P& p, int le, int q, TItem& t) {
    const int which = q >> 6, j = q & 63;
    t.src = (which ? p.w3 : p.w1) + (size_t)le * D * HID; t.ldn = HID; t.N = HID; t.K = D; t.kscale = p.norm_ffn + (le >> 5) * D;
    t.dst = p.W13T() + (size_t)le * 512 * D + (size_t)which * 256 * D; t.k0 = (j & 15) * 64; t.n0 = (j >> 4) * 64;
}
template <class P> __device__ __forceinline__ void titem_w2(const P& p, int le, int j, TItem& t) {
    t.src = p.w2 + (size_t)le * HID * D; t.ldn = D; t.N = D; t.K = HID; t.kscale = nullptr; t.dst = p.W2T() + (size_t)le * D * HID; t.k0 = (j & 3) * 64; t.n0 = (j >> 2) * 64;
}
template <class P> __device__ __forceinline__ void titem_decode(const P& p, int set, int it, TItem& t) {
    int r = it;
    if (set == 0) {
        if (r < TI_IN) { t.src = p.w_in; t.ldn = INC; t.N = INC; t.K = D; t.kscale = p.norm_mix; t.dst = p.WinT(); t.k0 = (r & 15) * 64; t.n0 = (r >> 4) * 64; return; } r -= TI_IN;
        if (r < TI_O) { t.src = p.w_out; t.ldn = D; t.N = D; t.K = D; t.kscale = nullptr; t.dst = p.WoutT(); t.k0 = (r & 15) * 64; t.n0 = (r >> 4) * 64; return; } r -= TI_O;
        titem_w13(p, r >> 7, r & 127, t); return;
    }
    if (set == 1) {
        if (r < TI_2) { titem_w2(p, r >> 6, r & 63, t); return; } r -= TI_2;
        if (r < TI_F) { t.src = p.w_f; t.ldn = D; t.N = D; t.K = D; t.kscale = nullptr; t.dst = p.WfT(); t.k0 = (r & 15) * 64; t.n0 = (r >> 4) * 64; return; } r -= TI_F;
        titem_w13(p, 32 + (r >> 7), r & 127, t); return;
    }
    titem_w2(p, 32 + (r >> 6), r & 63, t);
}
template <class P> __device__ __forceinline__ void titem_batch4(const P& p, int set, int it, int step, int n, float* sm, int tid) {
    TItem t0, t1, t2, t3; float4 v0[2], v1[2], v2[2], v3[2]; float c0[2], c1[2], c2[2], c3[2];
    const bool h1 = it + step < n, h2 = it + 2 * step < n, h3 = it + 3 * step < n;
    titem_decode(p, set, it, t0); titem_load(t0, tid, v0, c0);
    if (h1) { titem_decode(p, set, it + step, t1); titem_load(t1, tid, v1, c1); }
    if (h2) { titem_decode(p, set, it + 2 * step, t2); titem_load(t2, tid, v2, c2); }
    if (h3) { titem_decode(p, set, it + 3 * step, t3); titem_load(t3, tid, v3, c3); }
    titem_lds(sm, tid, v0, c0); if (h1) titem_lds(sm + 4160, tid, v1, c1); if (h2) titem_lds(sm + 8320, tid, v2, c2); if (h3) titem_lds(sm + 12480, tid, v3, c3);
    __syncthreads();
    titem_store(t0, sm, tid); if (h1) titem_store(t1, sm + 4160, tid); if (h2) titem_store(t2, sm + 8320, tid); if (h3) titem_store(t3, sm + 12480, tid);
    __syncthreads();
}
__device__ __forceinline__ void rows_to_bf16_rstd(const float* __restrict__ in, bf16* __restrict__ outb, float* __restrict__ rstd, int gw, int nw, int lane) {
    for (int r = gw; r < T; r += 2 * nw) {
        const int r2 = r + nw;
        const float4* ip = (const float4*)(in + (size_t)r * D); const float4* ip2 = (const float4*)(in + (size_t)(r2 < T ? r2 : r) * D);
        float4 v[4], v2[4];
#pragma unroll
        for (int i = 0; i < 4; ++i) { v[i] = ip[lane + i * 64]; v2[i] = ip2[lane + i * 64]; }
        float ss = 0.f, ss2 = 0.f;
#pragma unroll
        for (int i = 0; i < 4; ++i) { ss += v[i].x * v[i].x + v[i].y * v[i].y + v[i].z * v[i].z + v[i].w * v[i].w; ss2 += v2[i].x * v2[i].x + v2[i].y * v2[i].y + v2[i].z * v2[i].z + v2[i].w * v2[i].w; }
        ss = wave_sum(ss, lane); ss2 = wave_sum(ss2, lane);
        if (lane == 0) { rstd[r] = rsqrtf(ss * (1.f / D) + EPS); if (r2 < T) rstd[r2] = rsqrtf(ss2 * (1.f / D) + EPS); }
        u32x2* op = (u32x2*)(outb + (size_t)r * D);
#pragma unroll
        for (int i = 0; i < 4; ++i) { u32x2 o; o.x = cvt_pk_bf16(v[i].x, v[i].y); o.y = cvt_pk_bf16(v[i].z, v[i].w); op[lane + i * 64] = o; }
        if (r2 < T) { u32x2* op2 = (u32x2*)(outb + (size_t)r2 * D);
#pragma unroll
            for (int i = 0; i < 4; ++i) { u32x2 o; o.x = cvt_pk_bf16(v2[i].x, v2[i].y); o.y = cvt_pk_bf16(v2[i].z, v2[i].w); op2[lane + i * 64] = o; } }
    }
}

struct EpiInProj {
    typedef mk::BMapQK BMap;
    bf16* Qb; const float* rstd; const float* qkn; float* dt; const float* dt_bias;
    __device__ __forceinline__ void operator()(const f32x4 (&acc)[2][2][4][2], const Unit& u, int wr, int wc, int fr, int fq) const {
        const int row0 = u.pm * 256 + wr * 64 + fr, pn = u.pn;
        float rs[2][4];
#pragma unroll
        for (int ai = 0; ai < 2; ++ai)
#pragma unroll
            for (int m = 0; m < 4; ++m) rs[ai][m] = rstd[row0 + ai * 128 + m * 16];
        if (pn < 11) {
            bf16* dst = Qb + (size_t)(pn < 8 ? (pn >> 1) : 4) * T * 512;
            const int ld = pn < 8 ? 512 : 768;
            const int cbase = (pn < 8 ? (pn & 1) * 256 : (pn - 8) * 256) + wc * 64 + 8 * fq;
            f32x4 ww[2][2];
            { const float* w = qkn + (pn < 2 ? 0 : 64);
#pragma unroll
              for (int bj = 0; bj < 2; ++bj)
#pragma unroll
                for (int n = 0; n < 2; ++n) ww[bj][n] = pn < 4 ? *(const f32x4*)(w + 32 * bj + 8 * fq + 4 * n) : (f32x4){1.f, 1.f, 1.f, 1.f}; }
            const int ln = fq * 16 + fr;
#pragma unroll
            for (int ai = 0; ai < 2; ++ai)
#pragma unroll
                for (int m = 0; m < 4; ++m) {
                    const int row = row0 + ai * 128 + m * 16;
                    f32x4 v[2][2]; float ss = 0.f;
#pragma unroll
                    for (int bj = 0; bj < 2; ++bj)
#pragma unroll
                        for (int n = 0; n < 2; ++n) { v[bj][n] = acc[ai][bj][m][n] * rs[ai][m]; ss += v[bj][n][0] * v[bj][n][0] + v[bj][n][1] * v[bj][n][1] + v[bj][n][2] * v[bj][n][2] + v[bj][n][3] * v[bj][n][3]; }
                    float sc = 1.f;
                    if (pn < 4) { ss += shx(ss, 16, ln); ss += shx(ss, 32, ln); sc = rsqrtf(ss * (1.f / 64.f) + EPS); }
#pragma unroll
                    for (int bj = 0; bj < 2; ++bj) { const f32x4 v0 = v[bj][0] * sc * ww[bj][0], v1 = v[bj][1] * sc * ww[bj][1];
                        u32x4 o; o.x = cvt_pk_bf16(v0[0], v0[1]); o.y = cvt_pk_bf16(v0[2], v0[3]); o.z = cvt_pk_bf16(v1[0], v1[1]); o.w = cvt_pk_bf16(v1[2], v1[3]);
                        *(u32x4*)(dst + (size_t)row * ld + cbase + 32 * bj) = o; }
                }
        } else if (wc == 0 && fq < 2) {
            const f32x4 b0 = *(const f32x4*)(dt_bias + 8 * fq), b1 = *(const f32x4*)(dt_bias + 8 * fq + 4);
#pragma unroll
            for (int ai = 0; ai < 2; ++ai)
#pragma unroll
                for (int m = 0; m < 4; ++m) {
                    const int row = row0 + ai * 128 + m * 16;
                    f32x4 o0, o1;
#pragma unroll
                    for (int e = 0; e < 4; ++e) { const float x0 = acc[ai][0][m][0][e] * rs[ai][m] + b0[e], x1 = acc[ai][0][m][1][e] * rs[ai][m] + b1[e];
                        o0[e] = x0 > 20.f ? x0 : __logf(1.f + __expf(x0)); o1[e] = x1 > 20.f ? x1 : __logf(1.f + __expf(x1)); }
                    *(f32x4*)(dt + (size_t)row * 16 + 8 * fq) = o0; *(f32x4*)(dt + (size_t)row * 16 + 8 * fq + 4) = o1;
                }
        }
        __builtin_amdgcn_s_waitcnt(0x0F70);
    }
};
template <bool F32IN> struct EpiResid {
    typedef mk::BMapPerm BMap;
    const float* basef; bf16* X;
    __device__ __forceinline__ void operator()(const f32x4 (&acc)[2][2][4][2], const Unit& u, int wr, int wc, int fr, int fq) const {
        const int row0 = u.pm * 256 + wr * 64 + fr, col0 = u.pn * 256 + wc * 32 + 8 * fq;
#pragma unroll
        for (int ai = 0; ai < 2; ++ai) {
            f32x4 bf[4][2][2]; u32x4 bb[4][2];
#pragma unroll
            for (int m = 0; m < 4; ++m)
#pragma unroll
                for (int bj = 0; bj < 2; ++bj) { const size_t o = (size_t)(row0 + ai * 128 + m * 16) * D + col0 + bj * 128;
                    if (F32IN) { bf[m][bj][0] = *(const f32x4*)(basef + o); bf[m][bj][1] = *(const f32x4*)(basef + o + 4); } else bb[m][bj] = *(const u32x4*)(X + o); }
#pragma unroll
            for (int m = 0; m < 4; ++m)
#pragma unroll
                for (int bj = 0; bj < 2; ++bj) { const size_t o = (size_t)(row0 + ai * 128 + m * 16) * D + col0 + bj * 128; float v[8];
                    if (F32IN) { v[0] = bf[m][bj][0][0]; v[1] = bf[m][bj][0][1]; v[2] = bf[m][bj][0][2]; v[3] = bf[m][bj][0][3]; v[4] = bf[m][bj][1][0]; v[5] = bf[m][bj][1][1]; v[6] = bf[m][bj][1][2]; v[7] = bf[m][bj][1][3]; }
                    else unpack8(bb[m][bj], v);
#pragma unroll
                    for (int e = 0; e < 4; ++e) { v[e] += acc[ai][bj][m][0][e]; v[4 + e] += acc[ai][bj][m][1][e]; }
                    *(u32x4*)(X + o) = pack8(v); }
        }
    }
};
struct EpiChan {
    typedef mk::BMapPerm BMap;
    bf16* ZT;
    __device__ __forceinline__ void operator()(const f32x4 (&acc)[2][2][4][2], const Unit& u, int wr, int wc, int fr, int fq) const {
        const int bg = u.aux & 255, a = u.aux >> 8;
        bf16* Z = ZT + (size_t)bg * 256 * 2048 + a * 512 + u.pn * 256 + wc * 32 + 8 * fq;
#pragma unroll
        for (int ai = 0; ai < 2; ++ai)
#pragma unroll
            for (int m = 0; m < 4; ++m) {
                const int r = ai * 128 + wr * 64 + m * 16 + fr;
#pragma unroll
                for (int bj = 0; bj < 2; ++bj) { const f32x4 v0 = acc[ai][bj][m][0], v1 = acc[ai][bj][m][1];
                    u32x4 o; o.x = cvt_pk_bf16(v0[0], v0[1]); o.y = cvt_pk_bf16(v0[2], v0[3]); o.z = cvt_pk_bf16(v1[0], v1[1]); o.w = cvt_pk_bf16(v1[2], v1[3]);
                    *(u32x4*)(Z + (size_t)r * 2048 + bj * 128) = o; }
            }
    }
};
struct EpiSeq {
    typedef mk::BMapPerm BMap;
    bf16* F; const float* pmid; const float* p512; u32x4* park;
    __device__ __forceinline__ void operator()(const f32x4 (&acc)[2][2][4][2], const Unit& u, int wr, int wc, int fr, int fq) const {
        const int bg = u.aux & 255, part = (u.aux >> 8) & 1, cls = u.aux >> 9, b = bg >> 2, g = bg & 3;
        u32x4* pk = park + (size_t)blockIdx.x * 16 * 512 + (wr * 4 + wc) * 64 + fq * 16 + fr;
        constexpr float nrm = 0.0013810679320049757f;
        const float sg = (fr & 1) ? -nrm : nrm;
        if (part == 0) {
#pragma unroll
            for (int bj = 0; bj < 2; ++bj) {
                const int col = bj * 128 + wc * 32 + 8 * fq;
                const f32x4 pm0 = *(const f32x4*)(pmid + bg * 256 + col), pm1 = *(const f32x4*)(pmid + bg * 256 + col + 4), ph0 = *(const f32x4*)(p512 + bg * 256 + col), ph1 = *(const f32x4*)(p512 + bg * 256 + col + 4);
                const f32x4 m0 = cls ? pm0 * -nrm : pm0 * nrm + ph0 * sg, m1 = cls ? pm1 * -nrm : pm1 * nrm + ph1 * sg;
#pragma unroll
                for (int ai = 0; ai < 2; ++ai)
#pragma unroll
                    for (int m = 0; m < 4; ++m) {
                        const f32x4 v0 = acc[ai][bj][m][0] + m0, v1 = acc[ai][bj][m][1] + m1;
                        u32x4 o; o.x = cvt_pk_bf16(v0[0], v0[1]); o.y = cvt_pk_bf16(v0[2], v0[3]); o.z = cvt_pk_bf16(v1[0], v1[1]); o.w = cvt_pk_bf16(v1[2], v1[3]);
                        pk[((ai * 2 + bj) * 4 + m) * 512] = o;
                    }
            }
        } else {
            u32x4 uu[16];
#pragma unroll
            for (int i = 0; i < 16; ++i) uu[i] = pk[i * 512];
#pragma unroll
            for (int ai = 0; ai < 2; ++ai)
#pragma unroll
                for (int m = 0; m < 4; ++m) {
                    const int sp = 2 * (u.pm * 256 + ai * 128 + wr * 64 + m * 16 + fr) + cls;
#pragma unroll
                    for (int bj = 0; bj < 2; ++bj) {
                        float uv[8]; unpack8(uu[(ai * 2 + bj) * 4 + m], uv);
                        float lo[8], hi[8];
#pragma unroll
                        for (int e = 0; e < 4; ++e) { const float va = acc[ai][bj][m][0][e], vb = acc[ai][bj][m][1][e];
                            lo[e] = uv[e] - va; hi[e] = uv[e] + va; lo[4 + e] = uv[4 + e] - vb; hi[4 + e] = uv[4 + e] + vb; }
                        const int col = g * 256 + bj * 128 + wc * 32 + 8 * fq;
                        *(u32x4*)(F + (size_t)(b * SEQ + sp) * D + col) = pack8(lo);
                        if (sp != 0) *(u32x4*)(F + (size_t)(b * SEQ + 2048 - sp) * D + col) = pack8(hi);
                    }
                }
        }
    }
};

template <bool UP> struct SchedMoe {
    static constexpr bool GATHER = UP; static constexpr bool BJUMP = false;
    const MK_LAS int* tend; const MK_LAS int* tcnt;
    const int4* list; const char* A; const char* W; int nct;
    __device__ __forceinline__ bool next(int i, Unit& u) const {
        const int total = tend[31] * nct;
        const int L = i * gridDim.x + blockIdx.x; if (L >= total) return false;
        int flat; { const int q = total / 8, r = total % 8, xcd = L % 8, off = L / 8; flat = (xcd < r ? xcd * (q + 1) : r * (q + 1) + (xcd - r) * q) + off; }
        const int ln = (int)(threadIdx.x & 31);
        const unsigned long long bal = __ballot(flat >= tend[ln] * nct);
        const int e = __builtin_popcountll(bal) >> 1;
        const int prow = e ? tend[e - 1] : 0, c = tcnt[e];
        const int loc = flat - prow * nct, rt = loc / nct, ct = loc - rt * nct;
        u.pm = prow + rt; u.pn = ct; u.aux = e; u.nvalid = min(256, c - rt * 256); u.lst = list + e * CAP + rt * 256;
        if (UP) { u.a = A; u.b = W + ((size_t)e * 512 * D + (size_t)ct * 128 * D) * 2; }
        else { u.a = A + (size_t)u.pm * 256 * HID * 2; u.b = W + ((size_t)e * D * HID + (size_t)ct * 256 * HID) * 2; }
        return true;
    }
    __device__ __forceinline__ int arow(const Unit& u, int r) const { if (UP) return r < u.nvalid ? (u.lst[r].x >> 1) : 0; return r; }
};
__device__ __forceinline__ void moe_tables(const int* cnt, MK_LAS unsigned char* lds, int tid) {
    MK_LAS int* tend = (MK_LAS int*)(lds + 131072); MK_LAS int* tcnt = tend + 32;
    if (tid < 64) {
        const int ln = tid & 31; const int c = cnt[ln * 32]; int v = (c + 255) >> 8;
#pragma unroll
        for (int o = 1; o < 32; o <<= 1) { const int t = __builtin_amdgcn_ds_bpermute((tid - o) << 2, v); if (ln >= o) v += t; }
        if (tid < 32) { tend[ln] = v; tcnt[ln] = c; }
    }
    __syncthreads();
}
__device__ __forceinline__ void pair_tables(const int* ccnt, MK_LAS unsigned char* lds, int tid) {
    MK_LAS int* ctend = (MK_LAS int*)(lds + 131072 + 1024); MK_LAS int* ccount = ctend + 128; MK_LAS int* cpair = ccount + 128; MK_LAS int* cbase = cpair + 128;
    if (tid >= 64 && tid < 128) {
        const int ln = tid - 64, c0 = 2 * ln, c1 = c0 + 1;
        const int n0 = c0 < 112 ? ccnt[c0 * 16] : 0, n1 = c1 < 112 ? ccnt[c1 * 16] : 0;
        const int v0 = (n0 + 255) >> 8, v1 = (n1 + 255) >> 8; int v = v0 + v1;
#pragma unroll
        for (int o = 1; o < 64; o <<= 1) { const int t = __builtin_amdgcn_ds_bpermute((ln - o) << 2, v); if (ln >= o) v += t; }
        ctend[c0] = v - v1; ctend[c1] = v; ccount[c0] = n0; ccount[c1] = n1; cbase[c0] = v - v1 - v0; cbase[c1] = v - v1;
#pragma unroll
        for (int j = 0; j < 2; ++j) { const int c = c0 + j, gi = c / 28; int rem = c - gi * 28, lo = 0;
#pragma unroll
            for (int k = 0; k < 7; ++k) { if (rem >= 7 - lo) { rem -= 7 - lo; ++lo; } }
            cpair[c] = (gi * 8 + lo) | ((gi * 8 + lo + 1 + rem) << 8); }
    }
    __syncthreads();
}
struct SchedPair {
    static constexpr bool GATHER = false; static constexpr bool BJUMP = true;
    const MK_LAS int* ctend; const int* tok; const char* A; const char* W;
    __device__ __forceinline__ bool next(int i, Unit& u) const {
        const int total = ctend[127] * 4;
        const int L = i * gridDim.x + blockIdx.x; if (L >= total) return false;
        int flat; { const int q = total / 8, r = total % 8, xcd = L % 8, off = L / 8; flat = (xcd < r ? xcd * (q + 1) : r * (q + 1) + (xcd - r) * q) + off; }
        const int ln = (int)(threadIdx.x & 63);
        const int c = __builtin_popcountll(__ballot(flat >= ctend[ln] * 4)) + __builtin_popcountll(__ballot(flat >= ctend[64 + ln] * 4));
        const int prow = c ? ctend[c - 1] : 0, cc = ctend[128 + c], pr = ctend[256 + c], elo = pr & 255, ehi = pr >> 8;
        const int loc = flat - prow * 4, rt = loc >> 2, ct = loc & 3;
        u.pm = prow + rt; u.pn = ct; u.aux = c; u.nvalid = min(256, cc - rt * 256); u.lst = (const int4*)(tok + (size_t)u.pm * 256);
        u.a = A + (size_t)u.pm * 256 * 512 * 2; u.b = W + ((size_t)elo * D * HID + (size_t)ct * 256 * HID) * 2; u.bj = (ehi - elo) * (D * HID * 2) - 4 * 128;
        return true;
    }
    __device__ __forceinline__ int arow(const Unit&, int r) const { return r; }
};
struct EpiUp2 {
    typedef mk::BMapUp BMap;
    bf16* HID2; int* tok; const MK_LAS int* cbase;
    __device__ __forceinline__ void operator()(const f32x4 (&acc)[2][2][4][2], const Unit& u, int wr, int wc, int fr, int fq) const {
        float rs[2][4], gt[2][4]; int dr[2][4], tk[2][4];
#pragma unroll
        for (int ai = 0; ai < 2; ++ai)
#pragma unroll
            for (int m = 0; m < 4; ++m) { const int r = ai * 128 + wr * 64 + m * 16 + fr; const int4 e = u.lst[r];
                const bool ok = r < u.nvalid; const int c = (e.w >> 16) & 127;
                rs[ai][m] = __int_as_float(e.z); gt[ai][m] = __int_as_float(e.y); tk[ai][m] = e.x >> 1;
                dr[ai][m] = ok ? ((cbase[c] * 256 + (e.w & 0x7fff)) * 2 + ((e.w >> 24) & 1)) : -1; }
        const bool rec = u.pn == 0 && wc == 0 && fq == 0;
#pragma unroll
        for (int ai = 0; ai < 2; ++ai)
#pragma unroll
            for (int m = 0; m < 4; ++m) {
                if (dr[ai][m] >= 0) {
                    float h[8];
#pragma unroll
                    for (int n = 0; n < 2; ++n)
#pragma unroll
                        for (int e = 0; e < 4; ++e) { const float a1 = acc[ai][0][m][n][e] * rs[ai][m], a3 = acc[ai][1][m][n][e] * rs[ai][m]; h[4 * n + e] = a1 * __builtin_amdgcn_rcpf(1.f + __expf(-a1)) * a3 * gt[ai][m]; }
                    *(u32x4*)(HID2 + (size_t)(dr[ai][m] >> 1) * 512 + (dr[ai][m] & 1) * 256 + u.pn * 128 + wc * 32 + 8 * fq) = pack8(h);
                    if (rec && !(dr[ai][m] & 1)) tok[dr[ai][m] >> 1] = tk[ai][m];
                }
            }
    }
};
template <bool FINAL> struct EpiPair {
    typedef mk::BMapPerm BMap;
    bf16* X; float* out;
    __device__ __forceinline__ void operator()(const f32x4 (&acc)[2][2][4][2], const Unit& u, int wr, int wc, int fr, int fq) const {
        const int* tk = (const int*)u.lst; const int col0 = u.pn * 256 + wc * 32 + 8 * fq;
        int tv[2][4];
#pragma unroll
        for (int ai = 0; ai < 2; ++ai)
#pragma unroll
            for (int m = 0; m < 4; ++m) { const int r = ai * 128 + wr * 64 + m * 16 + fr; const int t = tk[r]; tv[ai][m] = r < u.nvalid ? t : -1; }
#pragma unroll
        for (int ai = 0; ai < 2; ++ai) {
            u32x4 bb[4][2];
#pragma unroll
            for (int m = 0; m < 4; ++m)
#pragma unroll
                for (int bj = 0; bj < 2; ++bj) bb[m][bj] = *(const u32x4*)(X + (size_t)(tv[ai][m] < 0 ? 0 : tv[ai][m]) * D + col0 + bj * 128);
#pragma unroll
            for (int m = 0; m < 4; ++m)
#pragma unroll
                for (int bj = 0; bj < 2; ++bj) {
                    if (tv[ai][m] >= 0) {
                        const size_t o = (size_t)tv[ai][m] * D + col0 + bj * 128; float v[8]; unpack8(bb[m][bj], v);
#pragma unroll
                        for (int e = 0; e < 4; ++e) { v[e] += acc[ai][bj][m][0][e]; v[4 + e] += acc[ai][bj][m][1][e]; }
                        if (FINAL) { *(f32x4*)(out + o) = (f32x4){v[0], v[1], v[2], v[3]}; *(f32x4*)(out + o + 4) = (f32x4){v[4], v[5], v[6], v[7]}; }
                        else *(u32x4*)(X + o) = pack8(v);
                    }
                }
        }
        __builtin_amdgcn_s_waitcnt(0x0F70);
    }
};
struct SchedChan {
    static constexpr bool GATHER = false; static constexpr bool BJUMP = false;
    const char* Dc; const char* X4;
    __device__ __forceinline__ bool next(int i, Unit& u) const {
        const int idx = i * gridDim.x + blockIdx.x; if (idx >= 512) return false;
        const int bg = idx >> 3, rem = idx & 7, a = rem >> 1, pn = rem & 1, b = bg >> 2, g = bg & 3;
        u.a = Dc + (size_t)((g * 2 + (a >> 1)) * 256) * 256 * 2; u.b = X4 + ((size_t)a << 24) + ((size_t)(b * 512 + pn * 256) * D + g * 256) * 2;
        u.pm = 0; u.pn = pn; u.aux = bg | (a << 8); u.nvalid = 256; u.lst = nullptr; return true;
    }
    __device__ __forceinline__ int arow(const Unit&, int r) const { return r; }
};
struct SchedSeq {
    static constexpr bool GATHER = false; static constexpr bool BJUMP = false;
    const char* CS; const char* ZT;
    __device__ __forceinline__ bool next(int i, Unit& u) const {
        const int tile = blockIdx.x + (i >> 1) * gridDim.x, part = i & 1; if (tile >= 256) return false;
        const int pm = tile & 1, cls = (tile >> 1) & 1, bg = tile >> 2, a = part ? 3 - cls : cls;
        u.a = CS + (size_t)((part * 2 + cls) * 512 + pm * 256) * 512 * 2; u.b = ZT + ((size_t)bg * 256 * 2048 + a * 512) * 2;
        u.pm = pm; u.pn = 0; u.aux = bg | (part << 8) | (cls << 9); u.nvalid = 256; u.lst = nullptr; return true;
    }
    __device__ __forceinline__ int arow(const Unit&, int r) const { return r; }
};

__device__ __forceinline__ void moe_router(const Params& p, int l, MK_LAS unsigned char* lds, int tid, int gw, int nw) {
    typedef short bfx8 __attribute__((ext_vector_type(8)));
    {
        const u32x4* src = (const u32x4*)((const bf16*)p.WR() + (size_t)l * 2 * 36864);
#pragma unroll
        for (int i = 0; i < 18; ++i) *(MK_LAS u32x4*)(lds + (tid + i * 512) * 16) = src[tid + i * 512];
        if (tid < 32) *(MK_LAS int*)(lds + 147456 + tid * 4) = 0;
        if (tid < 128) *(MK_LAS int*)(lds + 147456 + 256 + tid * 4) = 0;
        __syncthreads();
    }
    const int lane = tid & 63, r = lane & 15, q = lane >> 4;
    const float* rgb = p.rg_b + l * 4; const float* reb = p.re_b + l * 32;
    const MK_LAS bfx8* w01 = (const MK_LAS bfx8*)lds + (q * 2) * 16 + r;
    const MK_LAS bfx8* w2 = (const MK_LAS bfx8*)(lds + 65536) + q * 4 + (r & 3);
    for (int t0 = blockIdx.x * 8; t0 < T / 16; t0 += gridDim.x * 8) {
        const int tile = t0 + (tid >> 6);
        const bfx8* xr = (const bfx8*)(p.ACT() + (size_t)(tile * 16 + r) * D + 8 * q);
        f32x4 acc0 = {0.f, 0.f, 0.f, 0.f}, acc1 = acc0, acc2 = acc0, accs = acc0;
        bfx8 xa[32];
#pragma unroll
        for (int ks = 0; ks < 32; ++ks) xa[ks] = xr[ks * 4];
#pragma unroll
        for (int ks = 0; ks < 32; ++ks) {
            const bfx8 a = xa[ks];
            const bfx8 h0 = w01[ks * 128], h1 = w01[ks * 128 + 16], h2 = w2[ks * 16], l0 = w01[4608 + ks * 128], l1 = w01[4608 + ks * 128 + 16], l2 = w2[4608 + ks * 16];
            acc0 = __builtin_amdgcn_mfma_f32_16x16x32_bf16(a, h0, acc0, 0, 0, 0); acc1 = __builtin_amdgcn_mfma_f32_16x16x32_bf16(a, h1, acc1, 0, 0, 0); acc2 = __builtin_amdgcn_mfma_f32_16x16x32_bf16(a, h2, acc2, 0, 0, 0);
            acc0 = __builtin_amdgcn_mfma_f32_16x16x32_bf16(a, l0, acc0, 0, 0, 0); acc1 = __builtin_amdgcn_mfma_f32_16x16x32_bf16(a, l1, acc1, 0, 0, 0); acc2 = __builtin_amdgcn_mfma_f32_16x16x32_bf16(a, l2, acc2, 0, 0, 0);
            accs = __builtin_amdgcn_mfma_f32_16x16x32_bf16(a, a, accs, 0, 0, 0);
        }
        float ss;
        { const float d = (r & 3) == 0 ? accs[0] : (r & 3) == 1 ? accs[1] : (r & 3) == 2 ? accs[2] : accs[3];
          ss = shidx(d, (r >> 2) * 16 + r); }
        float* lg = p.LG() + (size_t)tile * 16 * 36;
#pragma unroll
        for (int g4 = 0; g4 < 4; ++g4) { lg[(4 * q + g4) * 36 + r] = acc0[g4]; lg[(4 * q + g4) * 36 + 16 + r] = acc1[g4]; if (r < 4) lg[(4 * q + g4) * 36 + 32 + r] = acc2[g4]; }
        asm volatile("s_waitcnt vmcnt(0)" ::: "memory");
        int E0 = 0, E1 = 0, pos0 = 0, pos1 = 0, cls = 0, cpos = 0, sl0 = 0; float gt0 = 0.f, gt1 = 0.f, rs = 0.f;
        MK_LAS int* lcnt = (MK_LAS int*)(lds + 147456); MK_LAS int* lbase = lcnt + 32; MK_LAS int* lcc = lcnt + 64; MK_LAS int* lcb = lcc + 128;
        if (lane < 16) {
            rs = rsqrtf(ss * (1.f / D) + EPS);
            const f32x4* lv = (const f32x4*)(lg + lane * 36);
            float raw[36];
#pragma unroll
            for (int i = 0; i < 9; ++i) { const f32x4 v = lv[i]; raw[4 * i] = v[0]; raw[4 * i + 1] = v[1]; raw[4 * i + 2] = v[2]; raw[4 * i + 3] = v[3]; }
            float gl[4];
#pragma unroll
            for (int c = 0; c < 4; ++c) gl[c] = raw[c] * rs + rgb[c];
            int gi = 0; float gm = gl[0];
#pragma unroll
            for (int c = 1; c < 4; ++c) if (gl[c] > gm) { gm = gl[c]; gi = c; }
            float gs = 0.f;
#pragma unroll
            for (int c = 0; c < 4; ++c) gs += expf(gl[c] - gm);
            const float g_p = 1.f / gs;
            float el[8];
#pragma unroll
            for (int e = 0; e < 8; ++e) { const float v = gi == 0 ? raw[4 + e] : gi == 1 ? raw[12 + e] : gi == 2 ? raw[20 + e] : raw[28 + e]; el[e] = v * rs + reb[gi * 8 + e]; }
            int e0 = 0; float m0 = el[0];
#pragma unroll
            for (int e = 1; e < 8; ++e) if (el[e] > m0) { m0 = el[e]; e0 = e; }
            int e1 = -1; float m1 = -3.4e38f;
#pragma unroll
            for (int e = 0; e < 8; ++e) if (e != e0 && el[e] > m1) { m1 = el[e]; e1 = e; }
            const float rr = expf(m1 - m0);
            gt0 = g_p / (1.f + rr); gt1 = g_p * rr / (1.f + rr);
            E0 = gi * 8 + e0; E1 = gi * 8 + e1;
            pos0 = __hip_atomic_fetch_add(lcnt + E0, 1, __ATOMIC_RELAXED, __HIP_MEMORY_SCOPE_WORKGROUP);
            pos1 = __hip_atomic_fetch_add(lcnt + E1, 1, __ATOMIC_RELAXED, __HIP_MEMORY_SCOPE_WORKGROUP);
            { const int lo = e0 < e1 ? e0 : e1, hi = e0 < e1 ? e1 : e0; cls = gi * 28 + ((lo * (15 - lo)) >> 1) + hi - lo - 1; sl0 = e0 > e1 ? 1 : 0; }
            cpos = __hip_atomic_fetch_add(lcc + cls, 1, __ATOMIC_RELAXED, __HIP_MEMORY_SCOPE_WORKGROUP);
        }
        __syncthreads();
        if (tid < 32) { const int n = lcnt[tid]; lbase[tid] = n ? atomicAdd(&p.cnt()[(l * 32 + tid) * 32], n) : 0; }
        if (tid >= 64 && tid < 192) { const int c = tid - 64, n = lcc[c]; lcb[c] = n ? atomicAdd(&p.ccnt()[(l * 128 + c) * 16], n) : 0; }
        __syncthreads();
        if (lane < 16) {
            const int t = tile * 16 + lane;
            const int w = (cls << 16) | (lcb[cls] + cpos);
            p.list()[E0 * CAP + lbase[E0] + pos0] = make_int4(t * 2, __float_as_int(gt0), __float_as_int(rs), w | (sl0 << 24));
            p.list()[E1 * CAP + lbase[E1] + pos1] = make_int4(t * 2 + 1, __float_as_int(gt1), __float_as_int(rs), w | ((1 - sl0) << 24));
        }
        __syncthreads();
        if (tid < 32) lcnt[tid] = 0;
        if (tid >= 64 && tid < 192) lcc[tid - 64] = 0;
        __syncthreads();
    }
    __syncthreads();
}
__device__ __forceinline__ float row_sq(const u32x4 (&x)[2], float (&w)[16]) {
    float ss = 0.f;
#pragma unroll
    for (int i = 0; i < 2; ++i) { float q[8]; unpack8(x[i], q);
#pragma unroll
        for (int j = 0; j < 8; ++j) { w[i * 8 + j] = q[j]; ss += q[j] * q[j]; } }
    return ss;
}
__device__ __forceinline__ void row16(const Params& p, int t, int lane, float (&w)[16], float& rs) {
    u32x4 x[2];
#pragma unroll
    for (int i = 0; i < 2; ++i) x[i] = *(const u32x4*)(p.ACT() + (size_t)t * D + lane * 8 + i * 512);
    rs = rsqrtf(wave_sum(row_sq(x, w), lane) * (1.f / D) + EPS);
}
__device__ __forceinline__ void mid_store(float* o, const float (&v)[16], int lane) {
#pragma unroll
    for (int i = 0; i < 2; ++i) { float* q = o + lane * 8 + i * 512;
        *(float4*)q = make_float4(v[i * 8], v[i * 8 + 1], v[i * 8 + 2], v[i * 8 + 3]); *(float4*)(q + 4) = make_float4(v[i * 8 + 4], v[i * 8 + 5], v[i * 8 + 6], v[i * 8 + 7]); }
}
__device__ __forceinline__ void moe_fold(const Params& p, int gw, int nw, int lane) {
    for (int task = gw; task < NB * 513; task += nw) {
        const int b = task < NB * 512 ? (task >> 9) : task - NB * 512, s = task < NB * 512 ? (task & 511) : 512;
        float w1[16], w2[16], r1, r2;
        if (s == 0 || s == 512) {
            row16(p, b * SEQ + (s ? 512 : 0), lane, w1, r1); row16(p, b * SEQ + (s ? 1536 : 1024), lane, w2, r2);
            float e[16], o[16];
#pragma unroll
            for (int j = 0; j < 16; ++j) { const float a = w1[j] * r1, c = w2[j] * r2; e[j] = s ? a + c : c; o[j] = s ? a - c : a; }
            if (s) { mid_store(p.HMID(1) + b * D, e, lane);
#pragma unroll
                for (int i = 0; i < 2; ++i) { float h0[8];
#pragma unroll
                    for (int j = 0; j < 8; ++j) h0[j] = o[i * 8 + j];
                    *(u32x4*)(p.X4(2) + ((size_t)b * 512) * D + lane * 8 + i * 512) = pack8(h0); } }
            else {
                mid_store(p.HMID(0) + b * D, e, lane);
#pragma unroll
                for (int i = 0; i < 2; ++i) { const size_t off = ((size_t)b * 512) * D + lane * 8 + i * 512; float h0[8];
#pragma unroll
                    for (int j = 0; j < 8; ++j) h0[j] = o[i * 8 + j];
                    const u32x4 pk = pack8(h0), z = {0u, 0u, 0u, 0u};
                    *(u32x4*)(p.X4(0) + off) = pk; *(u32x4*)(p.X4(1) + off) = pk; *(u32x4*)(p.X4(3) + off) = z; }
            }
            continue;
        }
        float w3[16], w4[16], r3, r4;
        row16(p, b * SEQ + s, lane, w1, r1); row16(p, b * SEQ + 1024 - s, lane, w2, r2); row16(p, b * SEQ + 1024 + s, lane, w3, r3); row16(p, b * SEQ + 2048 - s, lane, w4, r4);
#pragma unroll
        for (int i = 0; i < 2; ++i) {
            float ee[8], eo[8], oe[8], oo[8];
#pragma unroll
            for (int j = 0; j < 8; ++j) { const float h1 = w1[i * 8 + j] * r1, h2 = w2[i * 8 + j] * r2, h3 = w3[i * 8 + j] * r3, h4 = w4[i * 8 + j] * r4;
                const float e1 = h1 + h4, e2 = h2 + h3, o1 = h1 - h4, o2 = h2 - h3;
                ee[j] = e1 + e2; eo[j] = e1 - e2; oe[j] = o1 + o2; oo[j] = o1 - o2; }
            const size_t off = ((size_t)b * 512 + s) * D + lane * 8 + i * 512;
            *(u32x4*)(p.X4(0) + off) = pack8(ee); *(u32x4*)(p.X4(1) + off) = pack8(eo); *(u32x4*)(p.X4(2) + off) = pack8(oe); *(u32x4*)(p.X4(3) + off) = pack8(oo);
        }
    }
}
__device__ __forceinline__ void run_phase(const Params& p, int ph, float* sm, MK_LAS unsigned char* lds) {
    int tid = threadIdx.x; asm volatile("" : "+v"(tid));
    const int lane = tid & 63;
    const int gtid = blockIdx.x * blockDim.x + tid, gthreads = gridDim.x * blockDim.x;
    const int gw = gtid >> 6, nw = gthreads >> 6;
    switch (ph) {
    case 0: {
        if (blockIdx.x == 0 && tid < 64) { p.cnt()[tid * 32] = 0; if (tid == 0) { p.cnt()[64 * 32] = 0; p.cnt()[65 * 32] = 0; p.cnt()[64 * 32 + 8] = 0; p.cnt()[64 * 32 + 16] = 0; } p.qkn()[tid] = p.q_norm[tid]; p.qkn()[64 + tid] = p.k_norm[tid]; }
        if (blockIdx.x == 1 && tid < 256) p.ccnt()[tid * 16] = 0;
        rows_to_bf16_rstd(p.x, p.ACT(), p.rstd0(), gw, nw, lane);
        for (int it = blockIdx.x; it < TI_SET0; it += 4 * gridDim.x) titem_batch4(p, 0, it, (int)gridDim.x, TI_SET0, sm, tid);
        for (int i = gtid; i < 2 * 1024 * 36; i += gthreads) { const int l = i / (1024 * 36), r = i - l * 1024 * 36, k = r / 36, c = r - k * 36;
            const float v = p.norm_ffn[l * D + k] * (c < 4 ? p.rg_w[((size_t)l * D + k) * 4 + c] : p.re_w[((size_t)l * D + k) * 32 + c - 4]);
            const bf16 hi = f2bf(v), lo = f2bf(v - bf2f(hi));
            const int ks = k >> 5, q = (k >> 3) & 3, j = k & 7;
            const int idx = c < 32 ? ((((ks * 4 + q) * 2 + (c >> 4)) * 16 + (c & 15)) * 8 + j) : (32768 + (((ks * 4 + q) * 4 + (c - 32)) * 8 + j));
            bf16* img = (bf16*)p.WR() + (size_t)l * 2 * 36864;
            img[idx] = hi; img[36864 + idx] = lo; }
        const float* w2n = p.norm_mix + D;
        for (int i = gtid; i < 4 * 2 * 256 * 256; i += gthreads) {
            const int g = i >> 17, part = (i >> 16) & 1, co = (i >> 8) & 255, ch = i & 255;
            const float ang = 2.f * (float)((ch * co) & 255) * (1.f / 256.f);
            p.DcT()[i] = f2bf(w2n[g * 256 + ch] * (part ? __builtin_amdgcn_sinf(0.5f * ang) : __builtin_amdgcn_cosf(0.5f * ang)));
        }
        const float nrm = 1.f / sqrtf(2048.f * 256.f);
        for (int i = gtid; i < 4 * 512 * 64; i += gthreads) {
            const int mat = i >> 15, m = (i >> 6) & 511, k8 = (i & 63) * 8, sp = 2 * m + (mat & 1), part = mat >> 1;
            float v[8];
#pragma unroll
            for (int j = 0; j < 8; ++j) { const float turns = (float)((sp * (k8 + j)) & 2047) * (1.f / 2048.f); v[j] = nrm * (part ? __builtin_amdgcn_sinf(turns) : __builtin_amdgcn_cosf(turns)); }
            if (mat == 3 && k8 == 0) v[0] = (m & 1) ? -nrm : nrm;
            *(u32x4*)(p.CS() + ((size_t)mat * 512 + m) * 512 + k8) = pack8(v);
        }
    } break;
    case 1: {
        mk::SchedGrid S; S.A = (const char*)p.ACT(); S.Bt = (const char*)p.WinT(); S.nM = T / 256; S.nN = 12; S.lda = D; S.ldb = D;
        EpiInProj E; E.Qb = p.Qb(); E.rstd = p.rstd0(); E.qkn = p.qkn(); E.dt = p.dt(); E.dt_bias = p.dt_bias;
        mk::gemm_phase(lds, D, D, D, S, E);
    } break;
    case 3: {
        float a1 = p.lq1[lane] * p.lk1[lane], a2 = p.lq2[lane] * p.lk2[lane];
        a1 = wave_sum(a1, lane); a2 = wave_sum(a2, lane);
        const float lam_init = 0.2f;
        const float lam = expf(a1) - expf(a2) + lam_init;
        char* ldsg = (char*)sm;
        float smax;
        { float gq = fabsf(p.qkn()[lane]), gk = fabsf(p.qkn()[64 + lane]);
#pragma unroll
          for (int o_ = 32; o_ > 0; o_ >>= 1) { gq = fmaxf(gq, shx(gq, o_, lane)); gk = fmaxf(gk, shx(gk, o_, lane)); }
          smax = 8.f * 1.4426950408889634f * gq * gk * 1.02f + 0.5f; }
        for (int idx = blockIdx.x; idx < NB * 4 * 8; idx += gridDim.x) {
            int bh = (idx & 7) + 8 * (idx >> 6); if (idx >= (int)gridDim.x) bh ^= 3;
            const int qb = (idx >> 3) & 7, b = bh >> 2, h = bh & 3;
            const float sl2 = exp2f(-2.f * (float)(h + 1)) * 1.4426950408889634f;
            int jlo, ntl;
            { const float df = (smax + 160.f) / sl2; const int dmax = df < 4096.f ? (int)df + 1 : 4096;
              const int klo = max(0, qb * 256 - dmax), khi = min(SEQ - 1, qb * 256 + 255 + dmax);
              jlo = klo >> 6; int jhi = (khi >> 6) + 1;
              if ((jhi - jlo) & 1) { if (jlo > 0) --jlo; else ++jhi; }
              if (jhi - jlo < 4) { jlo = 0; jhi = SEQ / at::KVBLK; }
              jlo = __builtin_amdgcn_readfirstlane(jlo); ntl = __builtin_amdgcn_readfirstlane(jhi - jlo); }
            const bf16* Kh = p.Kb() + (size_t)b * SEQ * 512 + h * 128;
            const bf16* Vh = p.Vb() + (size_t)b * SEQ * 512 + h * 128;
            at::f32x16 o[4]; float l1, l0;
            {
                int tu = threadIdx.x; asm volatile("" : "+v"(tu));
                const int wid = tu >> 6, r32 = tu & 31, hi = (tu >> 5) & 1, qrow = qb * 256 + wid * 32 + r32;
                float* ws = (float*)(ldsg + 2 * at::SHM_V + 2 * at::SHM_K) + wid * 64;
                const bf16* Qw = p.Qb() + ((size_t)b * SEQ + qrow) * 512 + h * 128 + hi * 8;
                at::attn_pass(Qw, Kh, Vh, o, l0, ws, qrow, sl2, ldsg, tu, jlo, ntl);
                unsigned* park = (unsigned*)(ldsg + 53248) + tu;
#pragma unroll
                for (int d = 0; d < 4; ++d)
#pragma unroll
                    for (int r = 0; r < 8; ++r) park[(d * 8 + r) * 512] = at::cvtpk(o[d][2 * r], o[d][2 * r + 1]);
            }
            {
                int tu = threadIdx.x; asm volatile("" : "+v"(tu));
                const int wid = tu >> 6, r32 = tu & 31, hi = (tu >> 5) & 1, qrow = qb * 256 + wid * 32 + r32;
                float* ws = (float*)(ldsg + 2 * at::SHM_V + 2 * at::SHM_K) + wid * 64;
                const bf16* Qw = p.Qb() + ((size_t)b * SEQ + qrow) * 512 + h * 128 + 64 + hi * 8;
                at::attn_pass(Qw, Kh + 64, Vh, o, l1, ws, qrow, sl2, ldsg, tu, jlo, ntl);
            }
            {
                int tu = threadIdx.x; asm volatile("" : "+v"(tu));
                const int wid = tu >> 6, r32 = tu & 31, hi = (tu >> 5) & 1;
                float* ws = (float*)(ldsg + 2 * at::SHM_V + 2 * at::SHM_K) + wid * 64;
                const unsigned* park = (const unsigned*)(ldsg + 53248) + tu;
                if (hi == 0) { ws[r32] = 1.f / l0; ws[32 + r32] = lam / l1; }
                asm volatile("s_waitcnt lgkmcnt(0)" ::: "memory");
                float ssq[16];
#pragma unroll
                for (int r = 0; r < 16; ++r) { const int cr = at::crow(r, hi); const float i0 = ws[cr], i1 = ws[32 + cr]; float q = 0.f;
#pragma unroll
                    for (int d = 0; d < 4; ++d) { const unsigned w = park[(d * 8 + (r >> 1)) * 512]; const float o0 = __uint_as_float((r & 1) ? (w & 0xffff0000u) : (w << 16));
                        const float v = o0 * i0 - o[d][r] * i1; o[d][r] = v; q += v * v; }
                    ssq[r] = q; }
#pragma unroll
                for (int r = 0; r < 16; ++r) { float q = ssq[r]; { const int ln = tu & 63; q += shx(q, 1, ln); q += shx(q, 2, ln); q += shx(q, 4, ln); q += shx(q, 8, ln); q += shx(q, 16, ln); }
                    ssq[r] = rsqrtf(q * (1.f / 128.f) + EPS) * (1.f - lam_init); }
                bf16* pr = p.MIX() + ((size_t)b * SEQ + qb * 256 + wid * 32 + 4 * hi) * D + h * 128 + r32;
                const float w0 = p.subln[r32], w1 = p.subln[32 + r32], w2 = p.subln[64 + r32], w3 = p.subln[96 + r32];
#pragma unroll
                for (int r = 0; r < 16; ++r) {
                    asm volatile("" : "+v"(pr));
                    pr[0] = f2bf(o[0][r] * ssq[r] * w0); pr[32] = f2bf(o[1][r] * ssq[r] * w1); pr[64] = f2bf(o[2][r] * ssq[r] * w2); pr[96] = f2bf(o[3][r] * ssq[r] * w3);
                    pr += ((r & 3) == 3 ? 5 : 1) * D;
                }
                asm volatile("s_waitcnt lgkmcnt(0)" ::: "memory");
                __syncthreads();
            }
        }
        { MK_LAS int* slotw = (MK_LAS int*)(lds + 131072 + 512);
          for (;;) {
              __syncthreads();
              if (tid == 0) *slotw = atomicAdd(&p.cnt()[64 * 32 + 16], 1);
              __syncthreads();
              const int u = *slotw; if (u >= NB * 32) break;
              sd::s1_unit(p.XBC(), p.conv_w, p.conv_b, p.dt(), p.a_log, p.SLOC(), p.TOT(), u, (char*)sm);
          } }
    } break;
    case 5: sd::s2_scan(p.SLOC(), p.TOT(), gtid, gthreads); break;
    case 6: {
        for (int u = blockIdx.x; u < NB * 32; u += gridDim.x) sd::s3_unit(p.XBC(), p.conv_w, p.conv_b, p.dt(), p.a_log, p.d_skip, p.SLOC(), p.Zb(), p.ssd_norm, p.MIX(), u, (char*)sm);
    } break;
    case 7: {
        mk::SchedGrid S; S.A = (const char*)p.MIX(); S.Bt = (const char*)p.WoutT(); S.nM = T / 256; S.nN = 4; S.lda = D; S.ldb = D;
        EpiResid<false> E; E.basef = nullptr; E.X = p.ACT();
        mk::gemm_phase(lds, D, D, D, S, E);
    } break;
    case 8: moe_router(p, 0, lds, tid, gw, nw); break;
    case 9: case 16: {
        const int l = ph == 9 ? 0 : 1;
        moe_tables(p.cnt() + l * 32 * 32, lds, tid);
        SchedMoe<true> S; S.tend = (const MK_LAS int*)(lds + 131072); S.tcnt = S.tend + 32; S.list = p.list(); S.A = (const char*)p.ACT(); S.W = (const char*)(p.W13T() + (size_t)l * 32 * 512 * D); S.nct = 2;
        pair_tables(p.ccnt() + l * 128 * 16, lds, tid);
        EpiUp2 E; E.HID2 = p.HID2(); E.tok = p.tok(); E.cbase = (const MK_LAS int*)(lds + 131072 + 1024) + 384;
        mk::gemm_phase(lds, D, D, D, S, E);
        {
            MK_LAS int* slotw = (MK_LAS int*)(lds + 131072 + 512);
            const int nset = l == 0 ? TI_SET1 : TI_SET2, ncap = l == 0 ? TI_SET1_A : TI_SET2;
            for (;;) {
                __syncthreads();
                if (tid == 0) *slotw = atomicAdd(&p.cnt()[(64 + l) * 32], 4);
                __syncthreads();
                const int it = *slotw; if (it >= ncap) break;
                titem_batch4(p, 1 + l, it, 1, nset, sm, tid);
            }
        }
    } break;
    case 10: case 17: {
        const int l = ph == 10 ? 0 : 1;
        {
            pair_tables(p.ccnt() + l * 128 * 16, lds, tid);
            SchedPair S; S.ctend = (const MK_LAS int*)(lds + 131072 + 1024); S.tok = p.tok(); S.A = (const char*)p.HID2(); S.W = (const char*)(p.W2T() + (size_t)l * 32 * D * HID);
            if (l == 1) { EpiPair<true> E; E.X = p.ACT(); E.out = p.out; mk::gemm_phase(lds, 2 * HID, 2 * HID, HID, S, E); }
            else { EpiPair<false> E; E.X = p.ACT(); E.out = nullptr; mk::gemm_phase(lds, 2 * HID, 2 * HID, HID, S, E);
                MK_LAS int* slotw = (MK_LAS int*)(lds + 131072 + 512);
                for (;;) {
                    __syncthreads();
                    if (tid == 0) *slotw = atomicAdd(&p.cnt()[64 * 32 + 8], 4);
                    __syncthreads();
                    const int it = TI_SET1_A + *slotw; if (it >= TI_SET1) break;
                    titem_batch4(p, 1, it, 1, TI_SET1, sm, tid);
                } }
            break;
        }
    } break;
    case 11: moe_fold(p, gw, nw, lane); break;
    case 12: {
        {
            const int i = gtid >> 3, part = gtid & 7;
            if (i < 64 * 256) {
                const int bg = i >> 8, c = i & 255, b = bg >> 2, g = bg & 3;
#pragma unroll 1
                for (int k = 0; k < 2; ++k) {
                    const float* hm = p.HMID(k) + b * D + g * 256 + part * 32; const bf16* dc = p.DcT() + ((size_t)(g * 2) * 256 + c) * 256 + part * 32;
                    u32x4 dv[4]; f32x4 hv[8];
#pragma unroll
                    for (int q = 0; q < 4; ++q) dv[q] = *(const u32x4*)(dc + q * 8);
#pragma unroll
                    for (int q = 0; q < 8; ++q) hv[q] = *(const f32x4*)(hm + q * 4);
                    float a = 0.f;
#pragma unroll
                    for (int q = 0; q < 4; ++q) { float f[8]; unpack8(dv[q], f);
#pragma unroll
                        for (int j = 0; j < 4; ++j) { a = fmaf(hv[2 * q][j], f[j], a); a = fmaf(hv[2 * q + 1][j], f[4 + j], a); } }
                    a += shx(a, 1, lane); a += shx(a, 2, lane); a += shx(a, 4, lane);
                    if (part == 0) p.PMID(k)[i] = a;
                }
            }
        }
        SchedChan S; S.Dc = (const char*)p.DcT(); S.X4 = (const char*)p.X4(0);
        EpiChan E; E.ZT = p.ZT();
        mk::gemm_phase(lds, 256, 256, D, S, E);
    } break;
    case 13: {
        {
            const int i = gtid >> 3, part = gtid & 7;
            if (i < 64 * 256) {
                const int bg = i >> 8, c = i & 255, b = bg >> 2, g = bg & 3;
                const bf16* z = p.ZT() + ((size_t)bg * 256 + c) * 2048 + part * 64;
                u32x4 zv[8];
#pragma unroll
                for (int k = 0; k < 8; ++k) zv[k] = *(const u32x4*)(z + k * 8);
                float a = 0.f;
#pragma unroll
                for (int k = 0; k < 8; ++k) { float f[8]; unpack8(zv[k], f); a += (f[0] - f[1]) + (f[2] - f[3]) + (f[4] - f[5]) + (f[6] - f[7]); }
                a += shx(a, 1, lane); a += shx(a, 2, lane); a += shx(a, 4, lane);
                if (part == 0) p.MIX()[(size_t)(b * SEQ + 1024) * D + g * 256 + c] = f2bf(0.0013810679320049757f * (a + p.PMID(1)[i] + p.PMID(0)[i]));
            }
        }
        SchedSeq S; S.CS = (const char*)p.CS(); S.ZT = (const char*)p.ZT();
        EpiSeq E; E.F = p.MIX(); E.pmid = p.PMID(0); E.p512 = p.PMID(1); E.park = (u32x4*)((unsigned char*)p.ZT() + ((size_t)64 << 20));
        mk::gemm_phase(lds, 512, 512, 2048, S, E);
    } break;
    case 14: {
        mk::SchedGrid S; S.A = (const char*)p.MIX(); S.Bt = (const char*)p.WfT(); S.nM = T / 256; S.nN = 4; S.lda = D; S.ldb = D;
        EpiResid<false> E; E.basef = nullptr; E.X = p.ACT();
        mk::gemm_phase(lds, D, D, D, S, E);
    } break;
    case 15: moe_router(p, 1, lds, tid, gw, nw); break;
    default: break;
    }
}

constexpr int LDS_BYTES = 163840;
#if !MK_ONE_LAUNCH
__global__ void __launch_bounds__(512, 2) k_phase(Params p, int ph) {
    extern __shared__ __attribute__((aligned(16))) unsigned char shm[];
    run_phase(p, ph, (float*)shm, (MK_LAS unsigned char*)shm);
}
#else
__global__ void __launch_bounds__(512, 2) k_mega(Params p) {
    extern __shared__ __attribute__((aligned(16))) unsigned char shm[];
    float* sm = (float*)shm; MK_LAS unsigned char* lds = (MK_LAS unsigned char*)shm;
    cg::grid_group grid = cg::this_grid();
    volatile MK_LAS unsigned* st = (volatile MK_LAS unsigned*)(lds + LDS_BYTES - 16);
    if (threadIdx.x == 0) { st[0] = 0u; st[1] = 0u; }
    __syncthreads();
    const XcdBarrier xbar = xcd_barrier_post(p.bar(), st);
#ifdef ONLY_PH
    run_phase(p, ONLY_PH, sm, lds); grid.sync(); xcd_barrier(xbar); return;
#endif
    if (gridDim.x == 0x7fffffffu) grid.sync();
    run_phase(p, 0, sm, lds); xcd_barrier(xbar); if (REP_MASK & 1u) { run_phase(p, 0, sm, lds); xcd_barrier(xbar); }
#define PH(n) run_phase(p, n, sm, lds); xcd_barrier(xbar); if (REP_MASK & (1u << n)) { run_phase(p, n, sm, lds); xcd_barrier(xbar); }
    PH(1) PH(3) PH(5) PH(6) PH(7) PH(8) PH(9) PH(10) PH(11) PH(12) PH(13) PH(14) PH(15) PH(16)
    run_phase(p, 17, sm, lds);
#undef PH
}
#endif

extern "C" void kernel_launch(void* const* d_in, const int* in_sizes, int n_in, void* d_out, int out_size, void* d_ws, size_t ws_size, hipStream_t stream) {
    Params p{};
    const float* const* in = (const float* const*)d_in;
    p.x = in[0]; p.norm_mix = in[1]; p.norm_ffn = in[2]; p.w_in = in[3]; p.q_norm = in[4]; p.k_norm = in[5];
    p.lq1 = in[6]; p.lk1 = in[7]; p.lq2 = in[8]; p.lk2 = in[9]; p.subln = in[10]; p.conv_w = in[11]; p.conv_b = in[12];
    p.dt_bias = in[13]; p.a_log = in[14]; p.d_skip = in[15]; p.ssd_norm = in[16]; p.w_out = in[17]; p.w_f = in[18];
    p.rg_w = in[19]; p.rg_b = in[20]; p.re_w = in[21]; p.re_b = in[22]; p.w1 = in[23]; p.w3 = in[24]; p.w2 = in[25];
    p.out = (float*)d_out;
    p.ws = (unsigned char*)d_ws;
    if (ws_size < WS_END) { fprintf(stderr, "workspace too small: %zu < %zu\n", ws_size, (size_t)WS_END); return; }
#if MK_ONE_LAUNCH
    static int grid_blocks = 0;
    if (!grid_blocks) {
        int dev = 0, cus = 0, per_cu = 0;
        (void)hipGetDevice(&dev);
        (void)hipDeviceGetAttribute(&cus, hipDeviceAttributeMultiprocessorCount, dev);
        (void)hipFuncSetAttribute((const void*)k_mega, hipFuncAttributeMaxDynamicSharedMemorySize, LDS_BYTES);
        (void)hipOccupancyMaxActiveBlocksPerMultiprocessor(&per_cu, k_mega, 512, LDS_BYTES);
        if (per_cu > 1) per_cu = 1;
        grid_blocks = cus * per_cu;
    }
    (void)hipMemsetAsync((unsigned char*)d_ws + OFF_bar, 0, (size_t)XCD_BAR_WORDS * 4, stream);
    void* args[] = {&p};
    hipError_t e = hipLaunchCooperativeKernel((void*)k_mega, dim3(grid_blocks), dim3(512), args, LDS_BYTES, stream);
    if (e != hipSuccess) fprintf(stderr, "cooperative launch failed: %s (grid %d)\n", hipGetErrorString(e), grid_blocks);
#else
    (void)hipFuncSetAttribute((const void*)k_phase, hipFuncAttributeMaxDynamicSharedMemorySize, LDS_BYTES);
    for (int ph = 0; ph < NPHASE; ++ph) k_phase<<<256, 512, LDS_BYTES, stream>>>(p, ph);
#endif
}
```

```cpp
#include <hip/hip_runtime.h>
#include <hip/hip_cooperative_groups.h>
#include <cstdio>
namespace cg = cooperative_groups;

#ifndef REP_MASK
#define REP_MASK 0u
#endif
#ifndef MK_ONE_LAUNCH
#define MK_ONE_LAUNCH 1
#endif

constexpr int D = 1024, NB = 16, SEQ = 2048, T = NB * SEQ;
constexpr int INC = 2832;
constexpr int KOFF = 512, VOFF = 1024, ZOFF = 1536, XOFF = 2048, DTOFF = 2816;
constexpr int NE = 32, HID = 256;
constexpr int NPHASE = 19;
constexpr int CAP = 32768;
constexpr float EPS = 1e-6f;


__device__ __forceinline__ float shidx(float v, int src) { return __int_as_float(__builtin_amdgcn_ds_bpermute(src << 2, __float_as_int(v))); }
__device__ __forceinline__ float shx(float v, int o, int lane) { return shidx(v, lane ^ o); }
__device__ __forceinline__ float wave_sum(float v, int lane) {
#pragma unroll
    for (int o = 32; o > 0; o >>= 1) v += shx(v, o, lane);
    return v;
}
namespace mk {
#define MK_LAS __attribute__((address_space(3)))
typedef unsigned short bf16_t;
typedef short bf16x8 __attribute__((ext_vector_type(8)));
typedef float f32x4 __attribute__((ext_vector_type(4)));
typedef unsigned u32x4 __attribute__((ext_vector_type(4)));
typedef unsigned u32x2 __attribute__((ext_vector_type(2)));
constexpr int BM = 256, BK = 64, HALF = 128, HTB = HALF * BK * 2, STAGE_BYTES = 8 * HTB;

__host__ __device__ __forceinline__ int lds_byte(int r, int c) { const int st = (r >> 4) * 2 + (c >> 5), rr = r & 15, cc = c & 31, ob = rr * 64 + cc * 2; return st * 1024 + (ob ^ (((ob >> 9) & 1) << 5)); }
__host__ __device__ __forceinline__ void stage_rc(int b, int& R, int& C) { const int st = b / 1024, sb = b % 1024, swz = sb ^ (((sb >> 9) & 1) << 5); R = (st >> 1) * 16 + swz / 64; C = (st & 1) * 32 + (swz % 64) / 2; }
__host__ __device__ __forceinline__ int perm32(int rho) { const int n = rho >> 4, i = rho & 15; return 8 * (i >> 2) + 4 * n + (i & 3); }

__device__ __forceinline__ unsigned cvt_pk_bf16(float lo, float hi) { unsigned r; asm volatile("v_cvt_pk_bf16_f32 %0, %1, %2" : "=v"(r) : "v"(lo), "v"(hi)); return r; }
__device__ __forceinline__ float bf2f(bf16_t v) { return __uint_as_float(((unsigned)v) << 16); }
__device__ __forceinline__ bf16_t f2bf(float f) { unsigned u = __float_as_uint(f); u += 0x7FFFu + ((u >> 16) & 1u); return (bf16_t)(u >> 16); }

struct Unit { const char* a; const char* b; const int4* lst; int pm, pn, aux, nvalid, bj; };

__device__ __forceinline__ const char* uni_ptr(const char* p) { const unsigned lo = __builtin_amdgcn_readfirstlane((unsigned)(uintptr_t)p), hi = __builtin_amdgcn_readfirstlane((unsigned)((uintptr_t)p >> 32)); return (const char*)(((uintptr_t)hi << 32) | lo); }
__device__ __forceinline__ void uni_unit(Unit& u) { u.a = uni_ptr(u.a); u.b = uni_ptr(u.b); u.lst = (const int4*)uni_ptr((const char*)u.lst);
    u.pm = __builtin_amdgcn_readfirstlane(u.pm); u.pn = __builtin_amdgcn_readfirstlane(u.pn); u.aux = __builtin_amdgcn_readfirstlane(u.aux); u.nvalid = __builtin_amdgcn_readfirstlane(u.nvalid); }
struct BMapNat  { static __device__ __forceinline__ int row(int h, int R) { return h * 128 + R; } };
struct BMapPerm { static __device__ __forceinline__ int row(int h, int R) { return h * 128 + (R & ~31) + perm32(R & 31); } };
struct BMapUp   { static __device__ __forceinline__ int row(int h, int R) { return h * 256 + (R & ~31) + perm32(R & 31); } };
struct BMapQK   { static __device__ __forceinline__ int row(int h, int R) { return 64 * (R >> 5) + 32 * h + perm32(R & 31); } };

template <class Epi, class Sched, bool ALIGN_EPI = true, bool SP2 = true>
__device__ __forceinline__ void gemm_phase(MK_LAS unsigned char* lds, const int K, const int lda, const int ldb, const Sched& S, const Epi& E) {
    int tid = threadIdx.x; asm volatile("" : "+v"(tid));
    const int wid = __builtin_amdgcn_readfirstlane(tid >> 6), lane = tid & 63, wr = wid >> 2, wc = wid & 3, fr = lane & 15, fq = lane >> 4;
    int nt = K / BK; asm volatile("" : "+s"(nt));
    int RA[2], CA[2];
    unsigned voffB[2][2], voffA[2][2], voffAn[2][2];
#pragma unroll
    for (int i = 0; i < 2; ++i) { stage_rc(tid * 16 + i * 8192, RA[i], CA[i]); }
#pragma unroll
    for (int h = 0; h < 2; ++h)
#pragma unroll
        for (int i = 0; i < 2; ++i) voffB[h][i] = (unsigned)(Epi::BMap::row(h, RA[i]) * ldb + CA[i]) * 2u;
    const size_t kstep = (size_t)(BK * 2);
    const unsigned ldsw = (unsigned)wid * 1024u;
    const int aoff = lds_byte(wr * 64 + fr, fq * 8), boff = lds_byte(wc * 32 + fr, fq * 8);
#define MK_SA(b, h) (((b) * 2 + (h)) * HTB)
#define MK_SB(b, h) ((4 + (b) * 2 + (h)) * HTB)
#define MK_STAGE(bufoff, gbase, voff) do { _Pragma("unroll") for (int _i = 0; _i < 2; ++_i) \
        __builtin_amdgcn_global_load_lds((const unsigned*)((const char*)(gbase) + (voff)[_i]), (MK_LAS unsigned*)(lds + (bufoff) + ldsw + _i * 8192), 16, 0, 0); } while (0)
#define MK_LDA(dst, b, h) do { _Pragma("unroll") for (int m = 0; m < 4; ++m) _Pragma("unroll") for (int k = 0; k < 2; ++k) dst[m][k] = *(const MK_LAS bf16x8*)(lds + MK_SA(b, h) + aoff + m * 2048 + k * 1024); } while (0)
#define MK_LDB(dst, b, h) do { _Pragma("unroll") for (int n = 0; n < 2; ++n) _Pragma("unroll") for (int k = 0; k < 2; ++k) dst[n][k] = *(const MK_LAS bf16x8*)(lds + MK_SB(b, h) + boff + n * 2048 + k * 1024); } while (0)
#define MK_MMA(ai, bj, At, Bt) do { __builtin_amdgcn_s_setprio(1); _Pragma("unroll") for (int m = 0; m < 4; ++m) _Pragma("unroll") for (int n = 0; n < 2; ++n) _Pragma("unroll") for (int k = 0; k < 2; ++k) \
        acc[ai][bj][m][n] = __builtin_amdgcn_mfma_f32_16x16x32_bf16(Bt[n][k], At[m][k], acc[ai][bj][m][n], 0, 0, 0); __builtin_amdgcn_s_setprio(0); } while (0)
#define MK_WAIT_V(n) asm volatile("s_waitcnt vmcnt(" #n ")" ::: "memory")
#define MK_WAIT_L(n) asm volatile("s_waitcnt lgkmcnt(" #n ")" ::: "memory")
#define MK_BAR __builtin_amdgcn_s_barrier()
#define MK_SCHED __builtin_amdgcn_sched_barrier(0)
#define MK_SETA(dst, u) do { int _t = threadIdx.x; asm volatile("" : "+v"(_t)); _Pragma("unroll") for (int _i = 0; _i < 2; ++_i) { int _R, _C; stage_rc(_t * 16 + _i * 8192, _R, _C); _Pragma("unroll") for (int _h = 0; _h < 2; ++_h) dst[_h][_i] = (unsigned)(S.arow(u, _h * 128 + _R) * lda + _C) * 2u; } } while (0)
    Unit cur, nxt; int ui = 0;
    if (!S.next(0, cur)) return;
    uni_unit(cur); if constexpr (Sched::BJUMP) cur.bj = __builtin_amdgcn_readfirstlane(cur.bj);
    f32x4 acc[2][2][4][2];
#pragma unroll
    for (int a = 0; a < 2; ++a)
#pragma unroll
        for (int b = 0; b < 2; ++b)
#pragma unroll
            for (int m = 0; m < 4; ++m)
#pragma unroll
                for (int n = 0; n < 2; ++n) acc[a][b][m][n] = (f32x4){0.f, 0.f, 0.f, 0.f};
    bf16x8 At[4][2], B0[2][2], B1[2][2];
    const char* cA = cur.a; const char* cB = cur.b;
    MK_SETA(voffA, cur);
    if constexpr (SP2) {
        MK_STAGE(MK_SB(0, 0), cB, voffB[0]); MK_STAGE(MK_SB(0, 1), cB, voffB[1]); MK_STAGE(MK_SA(0, 0), cA, voffA[0]); MK_STAGE(MK_SA(0, 1), cA, voffA[1]);
        if (wr == 1) MK_BAR;
        MK_WAIT_V(2); MK_BAR;
        MK_STAGE(MK_SB(1, 0), cB + kstep, voffB[0]); MK_STAGE(MK_SA(1, 0), cA + kstep, voffA[0]); MK_STAGE(MK_SB(1, 1), cB + kstep, voffB[1]);
        MK_WAIT_V(6); MK_BAR;
    } else {
    MK_STAGE(MK_SB(0, 0), cB, voffB[0]); MK_STAGE(MK_SA(0, 0), cA, voffA[0]); MK_STAGE(MK_SB(0, 1), cB, voffB[1]); MK_STAGE(MK_SA(0, 1), cA, voffA[1]);
    if (wr == 1) MK_BAR;
    MK_WAIT_V(4); MK_BAR;
    MK_STAGE(MK_SB(1, 0), cB + kstep, voffB[0]); MK_STAGE(MK_SA(1, 0), cA + kstep, voffA[0]); MK_STAGE(MK_SB(1, 1), cB + kstep, voffB[1]);
    MK_WAIT_V(6); MK_BAR;
    }
    for (;;) {
        bool has_next = S.next(ui + 1, nxt);
        has_next = __builtin_amdgcn_readfirstlane((int)has_next) != 0; if (has_next) { uni_unit(nxt); if constexpr (Sched::BJUMP) nxt.bj = __builtin_amdgcn_readfirstlane(nxt.bj); }
        if constexpr (Sched::GATHER) { if (has_next) { MK_SETA(voffAn, nxt); } }
        const char* nA = has_next ? nxt.a : cA; const char* nB = has_next ? nxt.b : cB;

#pragma unroll 1
        for (int t = 0; t < nt; t += 2) {
            const bool last = (t == nt - 2);
            const char* a1 = cA + (size_t)(t + 1) * kstep;
            const char* a2 = last ? nA : cA + (size_t)(t + 2) * kstep; const char* b2 = last ? nB : cB + (size_t)(t + 2) * kstep;
            if constexpr (Sched::BJUMP) { if (!last && t >= 2) b2 += cur.bj; }
            const char* a3 = a2 + kstep; const char* b3 = b2 + kstep;
            if constexpr (SP2) {
            MK_LDB(B0, 0, 0); MK_LDB(B1, 0, 1); MK_SCHED; MK_LDA(At, 0, 0); MK_STAGE(MK_SA(1, 1), a1, voffA[1]);
            if constexpr (Sched::GATHER) { if (last && has_next) {
#pragma unroll
                for (int h = 0; h < 2; ++h)
#pragma unroll
                    for (int i = 0; i < 2; ++i) voffA[h][i] = voffAn[h][i]; } }
            MK_WAIT_V(8); MK_WAIT_L(0); MK_BAR; MK_MMA(0, 0, At, B0); MK_MMA(0, 1, At, B1); MK_BAR; MK_SCHED;
            MK_LDA(At, 0, 1); MK_STAGE(MK_SB(0, 0), b2, voffB[0]); MK_STAGE(MK_SB(0, 1), b2, voffB[1]); MK_STAGE(MK_SA(0, 0), a2, voffA[0]);
            MK_WAIT_V(8); MK_WAIT_L(0); MK_BAR; MK_MMA(1, 0, At, B0); MK_MMA(1, 1, At, B1); MK_BAR; MK_SCHED;
            MK_LDB(B0, 1, 0); MK_LDB(B1, 1, 1); MK_SCHED; MK_LDA(At, 1, 0); MK_STAGE(MK_SA(0, 1), a2, voffA[1]);
            MK_WAIT_V(8); MK_WAIT_L(0); MK_BAR; MK_MMA(0, 0, At, B0); MK_MMA(0, 1, At, B1); MK_BAR; MK_SCHED;
            MK_LDA(At, 1, 1); MK_STAGE(MK_SB(1, 0), b3, voffB[0]); MK_STAGE(MK_SB(1, 1), b3, voffB[1]); MK_STAGE(MK_SA(1, 0), a3, voffA[0]);
            MK_WAIT_V(8); MK_WAIT_L(0); MK_BAR; MK_MMA(1, 0, At, B0); MK_MMA(1, 1, At, B1); MK_BAR; MK_SCHED;
            } else {
            MK_LDB(B0, 0, 0); MK_SCHED; MK_LDA(At, 0, 0); MK_STAGE(MK_SA(1, 1), a1, voffA[1]);
            if constexpr (Sched::GATHER) { if (last && has_next) {
#pragma unroll
                for (int h = 0; h < 2; ++h)
#pragma unroll
                    for (int i = 0; i < 2; ++i) voffA[h][i] = voffAn[h][i]; } }
            MK_WAIT_L(8); MK_BAR; MK_WAIT_L(0); MK_MMA(0, 0, At, B0); MK_BAR; MK_SCHED;
            MK_LDB(B1, 0, 1); MK_STAGE(MK_SB(0, 0), b2, voffB[0]);
            MK_BAR; MK_WAIT_L(0); MK_MMA(0, 1, At, B1); MK_BAR;
            MK_LDA(At, 0, 1); MK_STAGE(MK_SA(0, 0), a2, voffA[0]);
            MK_BAR; MK_WAIT_L(0); MK_MMA(1, 0, At, B0); MK_BAR; MK_SCHED;
            MK_STAGE(MK_SB(0, 1), b2, voffB[1]);
            MK_WAIT_V(6); MK_BAR; MK_MMA(1, 1, At, B1); MK_BAR;
            MK_LDB(B0, 1, 0); MK_SCHED; MK_LDA(At, 1, 0); MK_STAGE(MK_SA(0, 1), a2, voffA[1]);
            MK_WAIT_L(8); MK_BAR; MK_WAIT_L(0); MK_MMA(0, 0, At, B0); MK_BAR; MK_SCHED;
            MK_LDB(B1, 1, 1); MK_STAGE(MK_SB(1, 0), b3, voffB[0]);
            MK_BAR; MK_WAIT_L(0); MK_MMA(0, 1, At, B1); MK_BAR;
            MK_LDA(At, 1, 1); MK_STAGE(MK_SA(1, 0), a3, voffA[0]);
            MK_BAR; MK_WAIT_L(0); MK_MMA(1, 0, At, B0); MK_BAR; MK_SCHED;
            MK_STAGE(MK_SB(1, 1), b3, voffB[1]);
            MK_WAIT_V(6); MK_BAR; MK_MMA(1, 1, At, B1); MK_BAR;
            }
        }
        if constexpr (ALIGN_EPI) { if (wr == 0) MK_BAR; }
        { int fr2 = fr, fq2 = fq; asm volatile("" : "+v"(fr2), "+v"(fq2)); E(acc, cur, wr, wc, fr2, fq2); }
        if (!has_next) break;
#pragma unroll
        for (int a = 0; a < 2; ++a)
#pragma unroll
            for (int b = 0; b < 2; ++b)
#pragma unroll
                for (int m = 0; m < 4; ++m)
#pragma unroll
                    for (int n = 0; n < 2; ++n) acc[a][b][m][n] = (f32x4){0.f, 0.f, 0.f, 0.f};
        cur = nxt; cA = nA; cB = nB; ++ui;
        if constexpr (ALIGN_EPI) { if (wr == 1) MK_BAR; }
    }
    MK_WAIT_V(0);
    if constexpr (!ALIGN_EPI) { if (wr == 0) MK_BAR; }
    MK_BAR;
#undef MK_SA
#undef MK_SB
#undef MK_STAGE
#undef MK_LDA
#undef MK_LDB
#undef MK_MMA
#undef MK_WAIT_V
#undef MK_WAIT_L
#undef MK_BAR
#undef MK_SCHED
#undef MK_SETA
}

struct SchedGrid {
    static constexpr bool GATHER = false; static constexpr bool BJUMP = false;
    const char* A; const char* Bt; int nM, nN, lda, ldb;
    __device__ __forceinline__ bool next(int i, Unit& u) const {
        const long L = (long)i * gridDim.x + blockIdx.x; const int nwg = nM * nN; if (L >= (long)nwg) return false;
        int wgid = (int)L; { const int q = nwg / 8, r = nwg % 8, xcd = wgid % 8, off = wgid / 8; wgid = (xcd < r ? xcd * (q + 1) : r * (q + 1) + (xcd - r) * q) + off; }
        const int nig = 8 * nN, gid = wgid / nig, fm = gid * 8, gsz = (nM - fm) < 8 ? (nM - fm) : 8;
        const int pm = fm + ((wgid % nig) % gsz), pn = (wgid % nig) / gsz;
        u.pm = pm; u.pn = pn; u.aux = 0; u.nvalid = 256; u.lst = nullptr; u.a = A + (size_t)pm * 256 * lda * 2; u.b = Bt + (size_t)pn * 256 * ldb * 2; return true;
    }
    __device__ __forceinline__ int arow(const Unit&, int r) const { return r; }
};
}

namespace at {
using bf16x8 = __attribute__((ext_vector_type(8))) short;
using s16x4  = __attribute__((ext_vector_type(4))) short;
using f32x16 = __attribute__((ext_vector_type(16))) float;
using u32x4  = __attribute__((ext_vector_type(4))) unsigned;
constexpr int KVBLK = 64, LDK = 512;
constexpr float C2 = 0.125f * 1.4426950408889634f;
constexpr float THR2 = 8.f * 1.4426950408889634f;
constexpr size_t SHM_V = KVBLK * 128 * 2, SHM_K = KVBLK * 64 * 2;
#define AT_KSWZ(row, colB) ((row) * 128 + ((colB) ^ ((((row) >> 1) & 7) << 4)))
#define AT_SBAR() __builtin_amdgcn_sched_barrier(0)
__device__ __forceinline__ int crow(int r, int hi) { return (r & 3) + 8 * (r >> 2) + 4 * hi; }
__device__ __forceinline__ unsigned cvtpk(float lo, float hi) { unsigned r; asm volatile("v_cvt_pk_bf16_f32 %0, %1, %2" : "=v"(r) : "v"(lo), "v"(hi)); return r; }

template <int MODE> __device__ __forceinline__ void smA(f32x16& p0, f32x16& p1, float base, float sl2, float slq, float Aq) {
#pragma unroll
  for (int r = 0; r < 16; ++r) { const float c = (float)((r & 3) + 8 * (r >> 2));
    if (MODE == 0) { p0[r] += fmaf(c, slq, Aq); p1[r] += fmaf(c + 32.f, slq, Aq); }
    else { p0[r] -= sl2 * fabsf(base - c); p1[r] -= sl2 * fabsf(base - c - 32.f); } }
#pragma unroll
  for (int r = 0; r < 16; ++r) p0[r] = __builtin_amdgcn_exp2f(p0[r]);
}
__device__ __forceinline__ void partialSM(f32x16& p0, f32x16& p1, float base, float sl2) {
  const int lo = __builtin_amdgcn_readfirstlane((int)base);
  if (lo >= 63) smA<0>(p0, p1, base, sl2, sl2, -sl2 * base);
  else if (lo <= -31) smA<0>(p0, p1, base, sl2, -sl2, sl2 * base);
  else smA<1>(p0, p1, base, sl2, 0.f, 0.f);
}
__device__ __forceinline__ void finishSM(f32x16& p0, f32x16& p1, float& l_reg, bf16x8& pa0, bf16x8& pa1, bf16x8& pa2, bf16x8& pa3) {
  float ps = 0;
#pragma unroll
  for (int r = 0; r < 16; ++r) ps += p0[r];
#pragma unroll
  for (int r = 0; r < 16; ++r) ps += p1[r];
  { auto rr = __builtin_amdgcn_permlane32_swap(__float_as_uint(ps), __float_as_uint(ps), false, false);
    ps = __uint_as_float(rr[0]) + __uint_as_float(rr[1]); }
  l_reg += ps;
#define AT_PK4(P, BASE, OUT) do { unsigned a0 = cvtpk(P[BASE + 0], P[BASE + 1]), a1 = cvtpk(P[BASE + 2], P[BASE + 3]);   \
    unsigned b0 = cvtpk(P[BASE + 4], P[BASE + 5]), b1 = cvtpk(P[BASE + 6], P[BASE + 7]);                              \
    auto r0 = __builtin_amdgcn_permlane32_swap(a0, b0, false, false); auto r1 = __builtin_amdgcn_permlane32_swap(a1, b1, false, false); \
    u32x4 w = {r0[0], r1[0], r0[1], r1[1]}; OUT = *reinterpret_cast<bf16x8*>(&w); } while (0)
  AT_PK4(p0, 0, pa0); AT_PK4(p0, 8, pa1); AT_PK4(p1, 0, pa2); AT_PK4(p1, 8, pa3);
#undef AT_PK4
}
__device__ __forceinline__ void qkt(f32x16& p0, f32x16& p1, const char* Ks, const bf16x8* qr, int r32, int hi) {
  p0 = f32x16{}; p1 = f32x16{};
#pragma unroll
  for (int d0 = 0; d0 < 4; ++d0) { const int cb = (d0 * 16 + hi * 8) * 2;
    bf16x8 b0 = *reinterpret_cast<const bf16x8*>(Ks + AT_KSWZ(r32, cb));
    bf16x8 b1 = *reinterpret_cast<const bf16x8*>(Ks + AT_KSWZ(32 + r32, cb));
    p0 = __builtin_amdgcn_mfma_f32_32x32x16_bf16(b0, qr[d0], p0, 0, 0, 0);
    p1 = __builtin_amdgcn_mfma_f32_32x32x16_bf16(b1, qr[d0], p1, 0, 0, 0); }
}
__device__ __forceinline__ int v_st(int k, int c) { const int kk = (k & ~0xC) | ((k & 4) << 1) | ((k & 8) >> 1); return ((kk >> 3) * 4 + (c >> 5)) * 512 + ((kk & 7) * 32 + (c & 31)) * 2; }
__device__ __forceinline__ int v_rd_base(int lane) { return ((lane & 3) << 3) | (((lane >> 2) & 3) << 6) | (((lane >> 4) & 1) << 5) | (((lane >> 5) & 1) << 8); }
constexpr int v_rd_off(int d0, int ks, int half) { return d0 * 512 + ks * 4096 + half * 2048; }
template <int OFF> __device__ __forceinline__ s16x4 tr_read(int vb) {
  s16x4 r; asm volatile("ds_read_b64_tr_b16 %0, %1 offset:%2" : "=&v"(r) : "v"(vb), "i"(OFF) : "memory"); return r;
}
template <int D0> __device__ __forceinline__ void pv_one(f32x16& od, int vb, bf16x8 pa0, bf16x8 pa1, bf16x8 pa2, bf16x8 pa3) {
  const s16x4 l0 = tr_read<v_rd_off(D0, 0, 0)>(vb), h0 = tr_read<v_rd_off(D0, 0, 1)>(vb), l1 = tr_read<v_rd_off(D0, 1, 0)>(vb), h1 = tr_read<v_rd_off(D0, 1, 1)>(vb);
  const s16x4 l2 = tr_read<v_rd_off(D0, 2, 0)>(vb), h2 = tr_read<v_rd_off(D0, 2, 1)>(vb), l3 = tr_read<v_rd_off(D0, 3, 0)>(vb), h3 = tr_read<v_rd_off(D0, 3, 1)>(vb);
  asm volatile("s_waitcnt lgkmcnt(0)" ::: "memory"); AT_SBAR();
#define AT_PK(L, H) __builtin_shufflevector(L, H, 0, 1, 2, 3, 4, 5, 6, 7)
  od = __builtin_amdgcn_mfma_f32_32x32x16_bf16(pa0, AT_PK(l0, h0), od, 0, 0, 0);
  od = __builtin_amdgcn_mfma_f32_32x32x16_bf16(pa1, AT_PK(l1, h1), od, 0, 0, 0);
  od = __builtin_amdgcn_mfma_f32_32x32x16_bf16(pa2, AT_PK(l2, h2), od, 0, 0, 0);
  od = __builtin_amdgcn_mfma_f32_32x32x16_bf16(pa3, AT_PK(l3, h3), od, 0, 0, 0);
#undef AT_PK
}
__device__ __forceinline__ void pv_d0(f32x16* o, int vb, bf16x8 pa0, bf16x8 pa1, bf16x8 pa2, bf16x8 pa3) {
  pv_one<0>(o[0], vb, pa0, pa1, pa2, pa3); pv_one<1>(o[1], vb, pa0, pa1, pa2, pa3); pv_one<2>(o[2], vb, pa0, pa1, pa2, pa3); pv_one<3>(o[3], vb, pa0, pa1, pa2, pa3);
}


typedef float f32x2 __attribute__((ext_vector_type(2)));
typedef __bf16 bf16x2v __attribute__((ext_vector_type(2)));
__device__ __forceinline__ unsigned cvtpk_b(float lo, float hi) { const f32x2 v = {lo, hi}; return __builtin_bit_cast(unsigned, __builtin_convertvector(v, bf16x2v)); }
#define AT_SWAP(a, b) __builtin_amdgcn_permlane32_swap(a, b, false, false)
__device__ __forceinline__ void qkt_fin(f32x16& n0, f32x16& n1, const char* Ks, const bf16x8* qr, int r32, int hi,
                                        f32x16& p0, f32x16& p1, float& l_reg, bf16x8& pa0, bf16x8& pa1, bf16x8& pa2, bf16x8& pa3) {
  f32x2 s2 = {0.f, 0.f};
  unsigned c0 = 0, c1 = 0, c2 = 0, c3 = 0;
  bf16x8 b0 = *reinterpret_cast<const bf16x8*>(Ks + AT_KSWZ(r32, (hi * 8) * 2)), b1 = *reinterpret_cast<const bf16x8*>(Ks + AT_KSWZ(32 + r32, (hi * 8) * 2));
#pragma unroll
  for (int d0 = 0; d0 < 4; ++d0) {
    bf16x8 nb0 = b0, nb1 = b1;
    if (d0 < 3) { const int cb = ((d0 + 1) * 16 + hi * 8) * 2; nb0 = *reinterpret_cast<const bf16x8*>(Ks + AT_KSWZ(r32, cb)); nb1 = *reinterpret_cast<const bf16x8*>(Ks + AT_KSWZ(32 + r32, cb)); }
    AT_SBAR();
    n0 = __builtin_amdgcn_mfma_f32_32x32x16_bf16(b0, qr[d0], n0, 0, 0, 0);
    AT_SBAR();
    {
      const int g = 2 * d0;
      s2 += (f32x2){p0[2 * g], p0[2 * g + 1]};
      if (g > 0) s2 += (f32x2){p1[2 * g - 2], p1[2 * g - 1]};
      if (g == 0) { c0 = cvtpk_b(p0[0], p0[1]); c1 = cvtpk_b(p0[2], p0[3]); }
      if (g == 2) { c0 = cvtpk_b(p0[8], p0[9]); c1 = cvtpk_b(p0[10], p0[11]); }
      if (g == 4) { c0 = cvtpk_b(p1[0], p1[1]); c1 = cvtpk_b(p1[2], p1[3]); }
      if (g == 6) { c0 = cvtpk_b(p1[8], p1[9]); c1 = cvtpk_b(p1[10], p1[11]); }
      asm volatile("" : "+v"(s2));
    }
    AT_SBAR();
    n1 = __builtin_amdgcn_mfma_f32_32x32x16_bf16(b1, qr[d0], n1, 0, 0, 0);
    AT_SBAR();
    {
      const int g = 2 * d0 + 1;
      s2 += (f32x2){p0[2 * g], p0[2 * g + 1]};
      s2 += (f32x2){p1[2 * g - 2], p1[2 * g - 1]};
      if (g == 1) { c2 = cvtpk_b(p0[4], p0[5]); c3 = cvtpk_b(p0[6], p0[7]); }
      if (g == 3) { c2 = cvtpk_b(p0[12], p0[13]); c3 = cvtpk_b(p0[14], p0[15]); }
      if (g == 5) { c2 = cvtpk_b(p1[4], p1[5]); c3 = cvtpk_b(p1[6], p1[7]); }
      if (g < 7) { const auto r0 = AT_SWAP(c0, c2); const auto r1 = AT_SWAP(c1, c3); const u32x4 w = {r0[0], r1[0], r0[1], r1[1]};
        if (g == 1) pa0 = __builtin_bit_cast(bf16x8, w); if (g == 3) pa1 = __builtin_bit_cast(bf16x8, w); if (g == 5) pa2 = __builtin_bit_cast(bf16x8, w); }
      asm volatile("" : "+v"(s2));
    }
    AT_SBAR();
    b0 = nb0; b1 = nb1;
  }
  {
    c2 = cvtpk_b(p1[12], p1[13]); c3 = cvtpk_b(p1[14], p1[15]);
    const auto r0 = AT_SWAP(c0, c2); const auto r1 = AT_SWAP(c1, c3); const u32x4 w = {r0[0], r1[0], r0[1], r1[1]}; pa3 = __builtin_bit_cast(bf16x8, w);
    s2 += (f32x2){p1[14], p1[15]};
    float ps = s2[0] + s2[1];
    const auto rr = AT_SWAP(__float_as_uint(ps), __float_as_uint(ps));
    l_reg += __uint_as_float(rr[0]) + __uint_as_float(rr[1]);
  }
}
template <int KS> __device__ __forceinline__ void v_group(int vb, s16x4 (&f)[8]) {
  f[0] = tr_read<v_rd_off(0, KS, 0)>(vb); f[1] = tr_read<v_rd_off(0, KS, 1)>(vb); f[2] = tr_read<v_rd_off(1, KS, 0)>(vb); f[3] = tr_read<v_rd_off(1, KS, 1)>(vb);
  f[4] = tr_read<v_rd_off(2, KS, 0)>(vb); f[5] = tr_read<v_rd_off(2, KS, 1)>(vb); f[6] = tr_read<v_rd_off(3, KS, 0)>(vb); f[7] = tr_read<v_rd_off(3, KS, 1)>(vb);
}
#define AT_VWAIT(N, f) asm volatile("s_waitcnt lgkmcnt(" #N ")" : "+v"(f[0]), "+v"(f[1]), "+v"(f[2]), "+v"(f[3]), "+v"(f[4]), "+v"(f[5]), "+v"(f[6]), "+v"(f[7]) :: "memory")
template <int C> __device__ __forceinline__ void psm_slice(f32x16& p0, f32x16& p1, f32x16& n0, f32x16& n1, float slq, float Aq) {
  constexpr int E = 2 * (C & 7);
  constexpr float k0 = (float)((E & 3) + 8 * (E >> 2) + (C >= 8 ? 32 : 0)), k1 = (float)(((E + 1) & 3) + 8 * ((E + 1) >> 2) + (C >= 8 ? 32 : 0));
  float a0 = fmaf(k0, slq, Aq), a1 = fmaf(k1, slq, Aq);
  asm volatile("" : "+v"(a0), "+v"(a1));
  if (C < 8) { n0[E] = a0; n0[E + 1] = a1; } else { n1[E] = a0; n1[E + 1] = a1; }
  p0[C] = __builtin_amdgcn_exp2f(p0[C]); p1[C] = __builtin_amdgcn_exp2f(p1[C]);
}
#define AT_PVG(PA, F, KS) do { \
    o[0] = __builtin_amdgcn_mfma_f32_32x32x16_bf16(PA, __builtin_shufflevector(F[0], F[1], 0, 1, 2, 3, 4, 5, 6, 7), o[0], 0, 0, 0); AT_SBAR(); psm_slice<4 * KS + 0>(p0, p1, n0, n1, slq, Aq); AT_SBAR(); \
    o[1] = __builtin_amdgcn_mfma_f32_32x32x16_bf16(PA, __builtin_shufflevector(F[2], F[3], 0, 1, 2, 3, 4, 5, 6, 7), o[1], 0, 0, 0); AT_SBAR(); psm_slice<4 * KS + 1>(p0, p1, n0, n1, slq, Aq); AT_SBAR(); \
    o[2] = __builtin_amdgcn_mfma_f32_32x32x16_bf16(PA, __builtin_shufflevector(F[4], F[5], 0, 1, 2, 3, 4, 5, 6, 7), o[2], 0, 0, 0); AT_SBAR(); psm_slice<4 * KS + 2>(p0, p1, n0, n1, slq, Aq); AT_SBAR(); \
    o[3] = __builtin_amdgcn_mfma_f32_32x32x16_bf16(PA, __builtin_shufflevector(F[6], F[7], 0, 1, 2, 3, 4, 5, 6, 7), o[3], 0, 0, 0); AT_SBAR(); psm_slice<4 * KS + 3>(p0, p1, n0, n1, slq, Aq); AT_SBAR(); } while (0)
__device__ __forceinline__ void pv_psm(f32x16* o, int vb, bf16x8 pa0, bf16x8 pa1, bf16x8 pa2, bf16x8 pa3, f32x16& p0, f32x16& p1, f32x16& n0, f32x16& n1, float slq, float Aq) {
  s16x4 fa[8], fb[8];
  v_group<0>(vb, fa); v_group<1>(vb, fb); AT_VWAIT(8, fa);
  AT_PVG(pa0, fa, 0);
  v_group<2>(vb, fa); AT_VWAIT(8, fb);
  AT_PVG(pa1, fb, 1);
  v_group<3>(vb, fb); AT_VWAIT(8, fa);
  AT_PVG(pa2, fa, 2);
  AT_VWAIT(0, fb);
  AT_PVG(pa3, fb, 3);
}
__device__ __forceinline__ void bias_side(float base, float sl2, float& slq, float& Aq, bool& straddle) {
  const int lo = __builtin_amdgcn_readfirstlane((int)base);
  const bool below = lo >= 63, above = lo <= -31;
  slq = above ? -sl2 : sl2; Aq = above ? sl2 * base : -sl2 * base; straddle = !(below || above);
}
__device__ __forceinline__ void bias_fix(f32x16& n0, f32x16& n1) {
#pragma unroll
  for (int r = 0; r < 16; ++r) { n0[r] = -fabsf(n0[r]); n1[r] = -fabsf(n1[r]); }
}
__device__ __forceinline__ void bias_tile(f32x16& n0, f32x16& n1, float base, float sl2) {
  float slq, Aq; bool st; bias_side(base, sl2, slq, Aq, st);
#pragma unroll
  for (int r = 0; r < 16; ++r) { const float c = (float)((r & 3) + 8 * (r >> 2)); n0[r] = fmaf(c, slq, Aq); n1[r] = fmaf(c + 32.f, slq, Aq); }
  if (st) bias_fix(n0, n1);
}
__device__ __forceinline__ void qkt_acc(f32x16& p0, f32x16& p1, const char* Ks, const bf16x8* qr, int r32, int hi) {
#pragma unroll
  for (int d0 = 0; d0 < 4; ++d0) { const int cb = (d0 * 16 + hi * 8) * 2;
    bf16x8 b0 = *reinterpret_cast<const bf16x8*>(Ks + AT_KSWZ(r32, cb));
    bf16x8 b1 = *reinterpret_cast<const bf16x8*>(Ks + AT_KSWZ(32 + r32, cb));
    p0 = __builtin_amdgcn_mfma_f32_32x32x16_bf16(b0, qr[d0], p0, 0, 0, 0);
    p1 = __builtin_amdgcn_mfma_f32_32x32x16_bf16(b1, qr[d0], p1, 0, 0, 0); }
}

__device__ __forceinline__ void attn_pass(const unsigned short* __restrict__ Qw, const unsigned short* __restrict__ Kh, const unsigned short* __restrict__ Vh,
                                          f32x16 (&o)[4], float& l_out, float* ws, int qrow, float sl2, char* lds, int tid, int jlo, int NT) {
  Kh += (long)jlo * KVBLK * LDK; Vh += (long)jlo * KVBLK * LDK; qrow -= jlo * KVBLK;
  const int lane = tid & 63, r32 = lane & 31, hi = lane >> 5;
  char* V_lds = lds; char* K_lds = lds + 2 * SHM_V;
  float l_reg = 0; bf16x8 qr[4];
#pragma unroll
  for (int d = 0; d < 4; ++d) o[d] = f32x16{};
#pragma unroll
  for (int d0 = 0; d0 < 4; ++d0) qr[d0] = *reinterpret_cast<const bf16x8*>(Qw + d0 * 16);
  const int sr = tid >> 4, sc = (tid & 15) * 8, vst0 = v_st(sr, sc), vst1 = v_st(32 + sr, sc);
  const int kr = tid >> 3, kc = (tid & 7) * 8, kst = AT_KSWZ(kr, kc * 2);
  const int vb0 = (int)(uintptr_t)(__attribute__((address_space(3))) char*)V_lds + v_rd_base(lane);
  struct { bf16x8 vs0, vs1, ks0; } sr_[2];
#define AT_SLOAD(i, k0) do { sr_[i].vs0 = *reinterpret_cast<const bf16x8*>(&Vh[(long)((k0) + sr) * LDK + sc]); sr_[i].vs1 = *reinterpret_cast<const bf16x8*>(&Vh[(long)((k0) + 32 + sr) * LDK + sc]); \
    sr_[i].ks0 = *reinterpret_cast<const bf16x8*>(&Kh[(long)((k0) + kr) * LDK + kc]); } while (0)
#define AT_SWRITE(b, i) do { *(bf16x8*)(V_lds + (b) * SHM_V + vst0) = sr_[i].vs0; *(bf16x8*)(V_lds + (b) * SHM_V + vst1) = sr_[i].vs1; \
    *(bf16x8*)(K_lds + (b) * SHM_K + kst) = sr_[i].ks0; } while (0)
#define AT_SWAIT() asm volatile("s_waitcnt vmcnt(3)" ::: "memory")
  f32x16 pA0, pA1, pB0, pB1; bf16x8 pa0, pa1, pa2, pa3;
  float base = (float)(qrow - 4 * hi);
  constexpr int SE = 0, SO = 1;
  AT_SLOAD(SE, 0); asm volatile("s_waitcnt vmcnt(0)" ::: "memory"); AT_SWRITE(0, SE); __syncthreads();
  bias_tile(pA0, pA1, base, sl2); qkt_acc(pA0, pA1, K_lds, qr, r32, hi);
#pragma unroll
  for (int r = 0; r < 16; ++r) { pA0[r] = __builtin_amdgcn_exp2f(pA0[r]); pA1[r] = __builtin_amdgcn_exp2f(pA1[r]); }
  base -= 64.f; bias_tile(pB0, pB1, base, sl2);
  AT_SLOAD(SO, KVBLK); AT_SLOAD(SE, 2 * KVBLK);
  AT_SWAIT(); AT_SWRITE(1, SO); __syncthreads();
#define AT_PVSM(VB, P0, P1, N0, N1) do { base -= 64.f; float slq_, Aq_; bool st_; bias_side(base, sl2, slq_, Aq_, st_); pv_psm(o, VB, pa0, pa1, pa2, pa3, P0, P1, N0, N1, slq_, Aq_); if (st_) bias_fix(N0, N1); } while (0)
  for (int j = 1; j + 1 < NT; j += 2) {
    AT_SBAR(); qkt_fin(pB0, pB1, K_lds + SHM_K, qr, r32, hi, pA0, pA1, l_reg, pa0, pa1, pa2, pa3); AT_SBAR();
    AT_SLOAD(SO, (j + 2) * KVBLK); AT_SBAR();
    AT_PVSM(vb0, pB0, pB1, pA0, pA1); AT_SBAR();
    __syncthreads(); AT_SWAIT(); AT_SWRITE(0, SE);
    __syncthreads();
    AT_SBAR(); qkt_fin(pA0, pA1, K_lds, qr, r32, hi, pB0, pB1, l_reg, pa0, pa1, pa2, pa3); AT_SBAR();
    if (j + 3 < NT) AT_SLOAD(SE, (j + 3) * KVBLK); AT_SBAR();
    AT_PVSM(vb0 + (int)SHM_V, pA0, pA1, pB0, pB1); AT_SBAR();
    __syncthreads(); AT_SWAIT(); AT_SWRITE(1, SO);
    __syncthreads();
  }
#undef AT_PVSM
  AT_SBAR(); qkt_acc(pB0, pB1, K_lds + SHM_K, qr, r32, hi);
  finishSM(pA0, pA1, l_reg, pa0, pa1, pa2, pa3); AT_SBAR();
  pv_d0(o, vb0, pa0, pa1, pa2, pa3);
#pragma unroll
  for (int r = 0; r < 16; ++r) { pB0[r] = __builtin_amdgcn_exp2f(pB0[r]); pB1[r] = __builtin_amdgcn_exp2f(pB1[r]); }
  __syncthreads();
  finishSM(pB0, pB1, l_reg, pa0, pa1, pa2, pa3); AT_SBAR();
  pv_d0(o, vb0 + (int)SHM_V, pa0, pa1, pa2, pa3);
  l_out = l_reg;
  asm volatile("s_waitcnt vmcnt(0)" ::: "memory");
  __syncthreads();
#undef AT_SLOAD
#undef AT_SWRITE
#undef AT_SWAIT
}
}

namespace sd {
using bf16x8 = __attribute__((ext_vector_type(8))) short;
using s16x4  = __attribute__((ext_vector_type(4))) short;
using f32x16 = __attribute__((ext_vector_type(16))) float;
using f32x4  = __attribute__((ext_vector_type(4))) float;
using u32x4  = __attribute__((ext_vector_type(4))) unsigned;
using u32x2  = __attribute__((ext_vector_type(2))) unsigned;
constexpr int RSX = 1088, RSB1 = 192, RSBC = 144, RSY = 1040;
constexpr int O_X = 0, O_B1 = 69632, O_W1 = O_B1 + 2 * 64 * RSB1;
constexpr int O_B3 = 69632, O_C3 = O_B3 + 2 * 64 * RSBC, O_SC = O_C3 + 2 * 64 * RSBC, O_EF = O_SC + 8 * 64 * 16;
constexpr float LOG2E = 1.4426950408889634f;
#define SD_LAS __attribute__((address_space(3)))
template <int OFF> __device__ __forceinline__ s16x4 trr(int addr) { s16x4 r; asm volatile("ds_read_b64_tr_b16 %0, %1 offset:%2" : "=&v"(r) : "v"(addr), "i"(OFF) : "memory"); return r; }
#define SD_PK(L, H) __builtin_shufflevector(L, H, 0, 1, 2, 3, 4, 5, 6, 7)
#define SD_LWAIT() do { asm volatile("s_waitcnt lgkmcnt(0)" ::: "memory"); __builtin_amdgcn_sched_barrier(0); } while (0)
__device__ __forceinline__ unsigned cvtpk(float lo, float hi) { unsigned r; asm volatile("v_cvt_pk_bf16_f32 %0, %1, %2" : "=v"(r) : "v"(lo), "v"(hi)); return r; }
__device__ __forceinline__ bf16x8 scale8(bf16x8 f, f32x4 wa, f32x4 wb) {
    const u32x4 u = *reinterpret_cast<const u32x4*>(&f); u32x4 o;
    o.x = cvtpk(__uint_as_float(u.x << 16) * wa[0], __uint_as_float(u.x & 0xffff0000u) * wa[1]);
    o.y = cvtpk(__uint_as_float(u.y << 16) * wa[2], __uint_as_float(u.y & 0xffff0000u) * wa[3]);
    o.z = cvtpk(__uint_as_float(u.z << 16) * wb[0], __uint_as_float(u.z & 0xffff0000u) * wb[1]);
    o.w = cvtpk(__uint_as_float(u.w << 16) * wb[2], __uint_as_float(u.w & 0xffff0000u) * wb[3]);
    return *reinterpret_cast<const bf16x8*>(&o);
}
__device__ __forceinline__ float wave_incl_scan(float v, int lane) {
#pragma unroll
    for (int o = 1; o < 64; o <<= 1) { const float t = shidx(v, lane - o); if (lane >= o) v += t; }
    return v;
}
__device__ __forceinline__ int tr_lane_base(int lane, int RS, int khi) { const int g = lane >> 4, i = lane & 15, q = i >> 2, pp = i & 3; return ((g >> 1) * khi + q) * RS + (16 * (g & 1) + 4 * pp) * 2; }

__device__ __forceinline__ void conv_task(const unsigned short* XBC, const float* cw, const float* cb, size_t tok0, int s0, int rg, int ch, char* dst, int rs) {
    float w[5][8], bias[8];
#pragma unroll
    for (int k = 0; k < 5; ++k) { const f32x4 a = *(const f32x4*)(cw + k * 768 + ch), b = *(const f32x4*)(cw + k * 768 + ch + 4);
        w[k][0] = a[0]; w[k][1] = a[1]; w[k][2] = a[2]; w[k][3] = a[3]; w[k][4] = b[0]; w[k][5] = b[1]; w[k][6] = b[2]; w[k][7] = b[3]; }
    { const f32x4 a = *(const f32x4*)(cb + ch), b = *(const f32x4*)(cb + ch + 4); bias[0] = a[0]; bias[1] = a[1]; bias[2] = a[2]; bias[3] = a[3]; bias[4] = b[0]; bias[5] = b[1]; bias[6] = b[2]; bias[7] = b[3]; }
    u32x4 raw[12];
#pragma unroll
    for (int i = 0; i < 12; ++i) { const int sq = s0 + rg * 8 + i - 2; raw[i] = (u32x4){0u, 0u, 0u, 0u};
        if (sq >= 0 && sq < SEQ) raw[i] = *(const u32x4*)(XBC + (tok0 + rg * 8 + i - 2) * 768 + ch); }
    float xr[12][8];
#pragma unroll
    for (int i = 0; i < 12; ++i) { xr[i][0] = __uint_as_float(raw[i].x << 16); xr[i][1] = __uint_as_float(raw[i].x & 0xffff0000u); xr[i][2] = __uint_as_float(raw[i].y << 16); xr[i][3] = __uint_as_float(raw[i].y & 0xffff0000u);
        xr[i][4] = __uint_as_float(raw[i].z << 16); xr[i][5] = __uint_as_float(raw[i].z & 0xffff0000u); xr[i][6] = __uint_as_float(raw[i].w << 16); xr[i][7] = __uint_as_float(raw[i].w & 0xffff0000u); }
#pragma unroll
    for (int r = 0; r < 8; ++r) {
        float a[8];
#pragma unroll
        for (int j = 0; j < 8; ++j) { float v = bias[j];
#pragma unroll
            for (int k = 0; k < 5; ++k) v = fmaf(w[k][j], xr[r + k][j], v);
            a[j] = v * __builtin_amdgcn_rcpf(1.f + __expf(-v)); }
        u32x4 o; o.x = cvtpk(a[0], a[1]); o.y = cvtpk(a[2], a[3]); o.z = cvtpk(a[4], a[5]); o.w = cvtpk(a[6], a[7]);
        *(u32x4*)(dst + r * rs) = o;
    }
}
template <int RSBx, bool WITH_C>
__device__ __forceinline__ void load_images(const unsigned short* XBC, const float* cw, const float* cb, size_t tok0, char* lds, int obase_b, int obase_c, int tid) {
    const int s0 = (int)(tok0 & (SEQ - 1));
    { const int rg = tid >> 6, c16 = tid & 63; conv_task(XBC, cw, cb, tok0, s0, rg, c16 * 8, lds + O_X + rg * 8 * RSX + c16 * 16, RSX); }
    if (tid < (WITH_C ? 256 : 128)) {
        const int c16 = tid & (WITH_C ? 31 : 15), rg = tid >> (WITH_C ? 5 : 4), isc = c16 >> 4, g = (c16 >> 3) & 1, wi = c16 & 7;
        conv_task(XBC, cw, cb, tok0, s0, rg, 512 + c16 * 8, lds + (isc ? obase_c : obase_b) + g * 64 * RSBx + rg * 8 * RSBx + wi * 16, RSBx);
    }
}

__device__ __forceinline__ void s1_unit(const unsigned short* XC, const float* cw, const float* cb, const float* dt, const float* a_log, unsigned short* Sloc, float* TOT, int unit, char* lds) {
    int tid = threadIdx.x; asm volatile("" : "+v"(tid));
    const int lane = tid & 63, h = __builtin_amdgcn_readfirstlane(tid >> 6), g = h >> 2, r32 = lane & 31, hi = lane >> 5;
    const size_t tok0 = (size_t)(unit >> 5) * SEQ + (unit & 31) * 64;
    const float dtf = dt[(tok0 + lane) * 16 + h], dtb = dt[(tok0 + lane) * 16 + 8 + h];
    load_images<RSB1, false>(XC, cw, cb, tok0, lds, O_B1, 0, tid);
    {
        const float af = dtf * -expf(a_log[h]), ab = dtb * -expf(a_log[8 + h]);
        const float cumf = wave_incl_scan(af, lane), cumb = wave_incl_scan(ab, lane);
        const float totf = shidx(cumf, 63), totb = shidx(cumb, 63);
        float* wsc = (float*)(lds + O_W1) + h * 128;
        wsc[lane] = expf(totf - cumf) * dtf; wsc[64 + lane] = expf(cumb - ab) * dtb;
        if (lane == 0) { TOT[(unit * 8 + h) * 2] = totf; TOT[(unit * 8 + h) * 2 + 1] = totb; }
    }
    __syncthreads();
    const int ldsb = (int)(uintptr_t)(SD_LAS char*)lds;
    const int xb = ldsb + O_X + tr_lane_base(lane, RSX, 8) + h * 128;
    const int bb = ldsb + O_B1 + g * 64 * RSB1 + tr_lane_base(lane, RSB1, 8);
    const float* wl = (const float*)(lds + O_W1) + h * 128 + 8 * hi;
    f32x16 acc[2][2][2];
#pragma unroll
    for (int d = 0; d < 2; ++d)
#pragma unroll
        for (int a = 0; a < 2; ++a)
#pragma unroll
            for (int b = 0; b < 2; ++b) acc[d][a][b] = f32x16{};
#define SD_S1_STEP(KS) do { \
        const s16x4 x0l = trr<(KS) * 16 * RSX>(xb), x0h = trr<(KS) * 16 * RSX + 4 * RSX>(xb), x1l = trr<(KS) * 16 * RSX + 64>(xb), x1h = trr<(KS) * 16 * RSX + 4 * RSX + 64>(xb); \
        const s16x4 b0l = trr<(KS) * 16 * RSB1>(bb), b0h = trr<(KS) * 16 * RSB1 + 4 * RSB1>(bb), b1l = trr<(KS) * 16 * RSB1 + 64>(bb), b1h = trr<(KS) * 16 * RSB1 + 4 * RSB1 + 64>(bb); \
        const f32x4 wfa = *(const f32x4*)(wl + (KS) * 16), wfb = *(const f32x4*)(wl + (KS) * 16 + 4), wba = *(const f32x4*)(wl + 64 + (KS) * 16), wbb = *(const f32x4*)(wl + 64 + (KS) * 16 + 4); \
        SD_LWAIT(); \
        const bf16x8 X0 = SD_PK(x0l, x0h), X1 = SD_PK(x1l, x1h), B0 = SD_PK(b0l, b0h), B1 = SD_PK(b1l, b1h); \
        const bf16x8 A0f = scale8(B0, wfa, wfb), A1f = scale8(B1, wfa, wfb), A0b = scale8(B0, wba, wbb), A1b = scale8(B1, wba, wbb); \
        acc[0][0][0] = __builtin_amdgcn_mfma_f32_32x32x16_bf16(A0f, X0, acc[0][0][0], 0, 0, 0); acc[0][0][1] = __builtin_amdgcn_mfma_f32_32x32x16_bf16(A0f, X1, acc[0][0][1], 0, 0, 0); \
        acc[0][1][0] = __builtin_amdgcn_mfma_f32_32x32x16_bf16(A1f, X0, acc[0][1][0], 0, 0, 0); acc[0][1][1] = __builtin_amdgcn_mfma_f32_32x32x16_bf16(A1f, X1, acc[0][1][1], 0, 0, 0); \
        acc[1][0][0] = __builtin_amdgcn_mfma_f32_32x32x16_bf16(A0b, X0, acc[1][0][0], 0, 0, 0); acc[1][0][1] = __builtin_amdgcn_mfma_f32_32x32x16_bf16(A0b, X1, acc[1][0][1], 0, 0, 0); \
        acc[1][1][0] = __builtin_amdgcn_mfma_f32_32x32x16_bf16(A1b, X0, acc[1][1][0], 0, 0, 0); acc[1][1][1] = __builtin_amdgcn_mfma_f32_32x32x16_bf16(A1b, X1, acc[1][1][1], 0, 0, 0); \
    } while (0)
    SD_S1_STEP(0); SD_S1_STEP(1); SD_S1_STEP(2); SD_S1_STEP(3);
#undef SD_S1_STEP
#pragma unroll
    for (int d = 0; d < 2; ++d) {
        unsigned short* dst = Sloc + ((size_t)(unit * 8 + h) * 2 + d) * 4096;
#pragma unroll
        for (int nt = 0; nt < 2; ++nt)
#pragma unroll
            for (int pt = 0; pt < 2; ++pt)
#pragma unroll
                for (int q4 = 0; q4 < 4; ++q4) { u32x2 o; o.x = cvtpk(acc[d][nt][pt][4 * q4], acc[d][nt][pt][4 * q4 + 1]); o.y = cvtpk(acc[d][nt][pt][4 * q4 + 2], acc[d][nt][pt][4 * q4 + 3]);
                    *(u32x2*)(dst + (32 * pt + r32) * 64 + 32 * nt + 8 * q4 + 4 * hi) = o; }
    }
    __syncthreads();
}

__device__ __forceinline__ void s2_scan(unsigned short* Sloc, const float* TOT, int gtid, int gthreads) {
    for (int id = gtid; id < NB * 8 * 2 * 512; id += gthreads) {
        const int e8 = id & 511, dir = (id >> 9) & 1, h = (id >> 10) & 7, b = id >> 13;
        const int c0 = dir ? 31 : 0;
        const long cstep = (long)(dir ? -1 : 1) * 8 * 2 * 4096;
        unsigned short* ptr = Sloc + ((size_t)((b * 32 + c0) * 8 + h) * 2 + dir) * 4096 + e8 * 8;
        const float* tp = TOT + ((b * 32 + c0) * 8 + h) * 2 + dir; const int tstep = (dir ? -1 : 1) * 16;
        float carry[8];
#pragma unroll
        for (int j = 0; j < 8; ++j) carry[j] = 0.f;
#pragma unroll 1
        for (int half = 0; half < 2; ++half) {
            u32x4 v[16]; float dec[16];
            { unsigned short* lp = ptr; const float* lt = tp;
#pragma unroll
              for (int cc = 0; cc < 16; ++cc) { v[cc] = *(const u32x4*)lp; dec[cc] = *lt; lp += cstep; lt += tstep; } }
#pragma unroll
            for (int cc = 0; cc < 16; ++cc) {
                const float dc = expf(dec[cc]);
                u32x4 o; o.x = cvtpk(carry[0], carry[1]); o.y = cvtpk(carry[2], carry[3]); o.z = cvtpk(carry[4], carry[5]); o.w = cvtpk(carry[6], carry[7]);
                *(u32x4*)ptr = o;
                const u32x4 w = v[cc];
                carry[0] = fmaf(carry[0], dc, __uint_as_float(w.x << 16)); carry[1] = fmaf(carry[1], dc, __uint_as_float(w.x & 0xffff0000u));
                carry[2] = fmaf(carry[2], dc, __uint_as_float(w.y << 16)); carry[3] = fmaf(carry[3], dc, __uint_as_float(w.y & 0xffff0000u));
                carry[4] = fmaf(carry[4], dc, __uint_as_float(w.z << 16)); carry[5] = fmaf(carry[5], dc, __uint_as_float(w.z & 0xffff0000u));
                carry[6] = fmaf(carry[6], dc, __uint_as_float(w.w << 16)); carry[7] = fmaf(carry[7], dc, __uint_as_float(w.w & 0xffff0000u));
                ptr += cstep; tp += tstep;
            }
        }
    }
}

__device__ __forceinline__ void s3_unit(const unsigned short* XC, const float* cw, const float* cb, const float* dt, const float* a_log, const float* d_skip, const unsigned short* Sin, const unsigned short* Zb,
                                        const float* ssd_norm, unsigned short* MIX, int unit, char* lds) {
    int tid = threadIdx.x; asm volatile("" : "+v"(tid));
    const int lane = tid & 63, h = __builtin_amdgcn_readfirstlane(tid >> 6), g = h >> 2, r32 = lane & 31, hi = lane >> 5;
    const size_t tok0 = (size_t)(unit >> 5) * SEQ + (unit & 31) * 64;
    const float dtf = dt[(tok0 + lane) * 16 + h], dtb = dt[(tok0 + lane) * 16 + 8 + h];
    bf16x8 sf[2][2][4];
    {
        const unsigned short* sp = Sin + (size_t)(unit * 8 + h) * 2 * 4096 + r32 * 64 + 8 * hi;
#pragma unroll
        for (int d = 0; d < 2; ++d)
#pragma unroll
            for (int pt = 0; pt < 2; ++pt)
#pragma unroll
                for (int ks = 0; ks < 4; ++ks) sf[d][pt][ks] = *(const bf16x8*)(sp + d * 4096 + pt * 32 * 64 + ks * 16);
    }
    load_images<RSBC, true>(XC, cw, cb, tok0, lds, O_B3, O_C3, tid);
    {
        const float af = dtf * -expf(a_log[h]), ab = dtb * -expf(a_log[8 + h]);
        const float cumf = wave_incl_scan(af, lane), cumb = wave_incl_scan(ab, lane);
        const float totb = shidx(cumb, 63), eb = cumb - ab;
        *(f32x4*)(lds + O_SC + (h * 64 + lane) * 16) = (f32x4){cumf * LOG2E, dtf, eb * LOG2E, dtb};
        float* ef = (float*)(lds + O_EF) + h * 128;
        ef[lane] = expf(cumf); ef[64 + lane] = expf(totb - eb);
    }
    __syncthreads();
    const int ldsb = (int)(uintptr_t)(SD_LAS char*)lds;
    const int xb = ldsb + O_X + tr_lane_base(lane, RSX, 4) + h * 128;
    const char* bimg = lds + O_B3 + g * 64 * RSBC + r32 * RSBC + 16 * hi;
    const char* cimg = lds + O_C3 + g * 64 * RSBC + r32 * RSBC + 16 * hi;
    const char* scb = lds + O_SC + (h * 64 + 4 * hi) * 16;
    const float Dh = d_skip[h];
    f32x16 Y[2][2];
#pragma unroll
    for (int a = 0; a < 2; ++a)
#pragma unroll
        for (int b = 0; b < 2; ++b) Y[a][b] = f32x16{};
#define SD_TILE(LT, ST) do { \
        f32x16 G = f32x16{}; \
        _Pragma("unroll") for (int ks = 0; ks < 4; ++ks) { const bf16x8 Af = *(const bf16x8*)(bimg + (ST) * 32 * RSBC + ks * 32), Bf = *(const bf16x8*)(cimg + (LT) * 32 * RSBC + ks * 32); \
            G = __builtin_amdgcn_mfma_f32_32x32x16_bf16(Af, Bf, G, 0, 0, 0); } \
        const f32x4 scl = *(const f32x4*)(lds + O_SC + (h * 64 + (LT) * 32 + r32) * 16); \
        _Pragma("unroll") for (int r = 0; r < 16; ++r) { \
            const f32x4 sc = *(const f32x4*)(scb + ((ST) * 32 + (r & 3) + 8 * (r >> 2)) * 16); \
            const int sl = (r & 3) + 8 * (r >> 2) + 4 * hi; \
            float f; \
            if ((ST) < (LT)) f = __builtin_amdgcn_exp2f(scl[0] - sc[0]) * sc[1]; \
            else if ((ST) > (LT)) f = __builtin_amdgcn_exp2f(sc[2] - scl[2]) * sc[3]; \
            else { const float ff = __builtin_amdgcn_exp2f(scl[0] - sc[0]) * sc[1], fb = __builtin_amdgcn_exp2f(sc[2] - scl[2]) * sc[3]; f = (sl <= r32 ? ff : 0.f) + (sl >= r32 ? fb : 0.f); } \
            G[r] = G[r] * f; if ((ST) == (LT)) G[r] += (sl == r32 ? Dh : 0.f); } \
        u32x4 w0, w1; w0.x = cvtpk(G[0], G[1]); w0.y = cvtpk(G[2], G[3]); w0.z = cvtpk(G[4], G[5]); w0.w = cvtpk(G[6], G[7]); \
        w1.x = cvtpk(G[8], G[9]); w1.y = cvtpk(G[10], G[11]); w1.z = cvtpk(G[12], G[13]); w1.w = cvtpk(G[14], G[15]); \
        const bf16x8 W0 = *reinterpret_cast<const bf16x8*>(&w0), W1 = *reinterpret_cast<const bf16x8*>(&w1); \
        const s16x4 a00l = trr<(ST) * 32 * RSX>(xb), a00h = trr<(ST) * 32 * RSX + 8 * RSX>(xb), a01l = trr<(ST) * 32 * RSX + 16 * RSX>(xb), a01h = trr<(ST) * 32 * RSX + 24 * RSX>(xb); \
        const s16x4 a10l = trr<(ST) * 32 * RSX + 64>(xb), a10h = trr<(ST) * 32 * RSX + 8 * RSX + 64>(xb), a11l = trr<(ST) * 32 * RSX + 16 * RSX + 64>(xb), a11h = trr<(ST) * 32 * RSX + 24 * RSX + 64>(xb); \
        SD_LWAIT(); \
        Y[LT][0] = __builtin_amdgcn_mfma_f32_32x32x16_bf16(SD_PK(a00l, a00h), W0, Y[LT][0], 0, 0, 0); Y[LT][0] = __builtin_amdgcn_mfma_f32_32x32x16_bf16(SD_PK(a01l, a01h), W1, Y[LT][0], 0, 0, 0); \
        Y[LT][1] = __builtin_amdgcn_mfma_f32_32x32x16_bf16(SD_PK(a10l, a10h), W0, Y[LT][1], 0, 0, 0); Y[LT][1] = __builtin_amdgcn_mfma_f32_32x32x16_bf16(SD_PK(a11l, a11h), W1, Y[LT][1], 0, 0, 0); \
    } while (0)
    SD_TILE(0, 0); SD_TILE(0, 1); SD_TILE(1, 0); SD_TILE(1, 1);
#undef SD_TILE
    {
        const float* ef = (const float*)(lds + O_EF) + h * 128;
#pragma unroll
        for (int lt = 0; lt < 2; ++lt) {
            bf16x8 Cf[4];
#pragma unroll
            for (int ks = 0; ks < 4; ++ks) Cf[ks] = *(const bf16x8*)(cimg + lt * 32 * RSBC + ks * 32);
#pragma unroll
            for (int d = 0; d < 2; ++d) {
                const float e = ef[d * 64 + lt * 32 + r32];
#pragma unroll
                for (int pt = 0; pt < 2; ++pt) {
                    f32x16 Tt = f32x16{};
#pragma unroll
                    for (int ks = 0; ks < 4; ++ks) Tt = __builtin_amdgcn_mfma_f32_32x32x16_bf16(sf[d][pt][ks], Cf[ks], Tt, 0, 0, 0);
#pragma unroll
                    for (int r = 0; r < 16; ++r) Y[lt][pt][r] = fmaf(Tt[r], e, Y[lt][pt][r]);
                }
            }
        }
    }
    __syncthreads();
#pragma unroll
    for (int lt = 0; lt < 2; ++lt)
#pragma unroll
        for (int pt = 0; pt < 2; ++pt)
#pragma unroll
            for (int q4 = 0; q4 < 4; ++q4) { u32x2 o; o.x = cvtpk(Y[lt][pt][4 * q4], Y[lt][pt][4 * q4 + 1]); o.y = cvtpk(Y[lt][pt][4 * q4 + 2], Y[lt][pt][4 * q4 + 3]);
                *(u32x2*)(lds + (lt * 32 + r32) * RSY + (h * 64 + pt * 32 + q4 * 8 + 4 * hi) * 2) = o; }
    __syncthreads();
    {
        u32x4 zv[8], yv[8];
#pragma unroll
        for (int i = 0; i < 8; ++i) { const int l = h * 8 + i; zv[i] = *(const u32x4*)(Zb + (tok0 + l) * 512 + lane * 8); yv[i] = *(const u32x4*)(lds + l * RSY + lane * 16); }
        const f32x4 n0 = *(const f32x4*)(ssd_norm + lane * 8), n1 = *(const f32x4*)(ssd_norm + lane * 8 + 4);
#pragma unroll
        for (int i = 0; i < 8; ++i) {
            const int l = h * 8 + i;
            float y[8], z[8];
            y[0] = __uint_as_float(yv[i].x << 16); y[1] = __uint_as_float(yv[i].x & 0xffff0000u); y[2] = __uint_as_float(yv[i].y << 16); y[3] = __uint_as_float(yv[i].y & 0xffff0000u);
            y[4] = __uint_as_float(yv[i].z << 16); y[5] = __uint_as_float(yv[i].z & 0xffff0000u); y[6] = __uint_as_float(yv[i].w << 16); y[7] = __uint_as_float(yv[i].w & 0xffff0000u);
            z[0] = __uint_as_float(zv[i].x << 16); z[1] = __uint_as_float(zv[i].x & 0xffff0000u); z[2] = __uint_as_float(zv[i].y << 16); z[3] = __uint_as_float(zv[i].y & 0xffff0000u);
            z[4] = __uint_as_float(zv[i].z << 16); z[5] = __uint_as_float(zv[i].z & 0xffff0000u); z[6] = __uint_as_float(zv[i].w << 16); z[7] = __uint_as_float(zv[i].w & 0xffff0000u);
            float ss = 0.f;
#pragma unroll
            for (int j = 0; j < 8; ++j) { y[j] = y[j] * (z[j] * __builtin_amdgcn_rcpf(1.f + __expf(-z[j]))); ss += y[j] * y[j]; }
#pragma unroll
            for (int o = 32; o > 0; o >>= 1) ss += shx(ss, o, lane);
            const float rs = rsqrtf(ss * (1.f / 512.f) + EPS);
            u32x4 o; o.x = cvtpk(y[0] * rs * n0[0], y[1] * rs * n0[1]); o.y = cvtpk(y[2] * rs * n0[2], y[3] * rs * n0[3]);
            o.z = cvtpk(y[4] * rs * n1[0], y[5] * rs * n1[1]); o.w = cvtpk(y[6] * rs * n1[2], y[7] * rs * n1[3]);
            *(u32x4*)(MIX + (tok0 + l) * D + 512 + lane * 8) = o;
        }
    }
    __syncthreads();
}
}

#define XB_TMO      128
#define XB_XCNT(j)  (256  + 64 * (j))
#define XB_XSUB(j)  (1280 + 64 * (j))
#define XB_XGEN(j)  (2304 + 64 * (j))
#define XB_TOP      3328
#define XB_TOPGEN   3392
#define XCD_BAR_WORDS 3456
#define XB_SPIN_CAP (1u << 22)
__device__ __forceinline__ unsigned xb_ld(unsigned* p)              { return __hip_atomic_load(p, __ATOMIC_RELAXED, __HIP_MEMORY_SCOPE_AGENT); }
__device__ __forceinline__ unsigned xb_add(unsigned* p, unsigned v) { return __hip_atomic_fetch_add(p, v, __ATOMIC_RELAXED, __HIP_MEMORY_SCOPE_AGENT); }
__device__ __forceinline__ unsigned xb_xcc_id() { return (unsigned)__builtin_amdgcn_s_getreg((3 << 11) | 20) & 0xFu; }
#define XB_SPIN(cond, bar) do { unsigned _sp = 0; while (cond) { __builtin_amdgcn_s_sleep(1); \
    if ((++_sp & 255u) == 0u) { if (xb_ld(&(bar)[XB_TMO])) break; if (_sp > XB_SPIN_CAP) { atomicAdd(&(bar)[XB_TMO], 1u); break; } } } } while (0)
struct XcdBarrier { unsigned* bar; unsigned x; volatile MK_LAS unsigned* st; };
__device__ __forceinline__ XcdBarrier xcd_barrier_post(unsigned* bar, volatile MK_LAS unsigned* st) {
    XcdBarrier b; b.bar = bar; b.x = xb_xcc_id(); b.st = st;
    if (threadIdx.x == 0) (void)xb_add(&bar[XB_XCNT(b.x)], 1u);
    return b;
}
__device__ __forceinline__ void xcd_barrier_complete(unsigned* bar, unsigned x, unsigned& nloc, unsigned& nx) {
    const unsigned G = gridDim.x * gridDim.y * gridDim.z;
    unsigned sum, cnt, mine, sp = 0u;
    for (;;) {
        sum = 0u; cnt = 0u; mine = 0u;
#pragma unroll
        for (unsigned j = 0; j < 16; ++j) { const unsigned c = xb_ld(&bar[XB_XCNT(j)]); sum += c; cnt += (c > 0u) ? 1u : 0u; mine = (j == x) ? c : mine; }
        if (sum == G) break;
        __builtin_amdgcn_s_sleep(1);
        if ((++sp & 255u) == 0u) { if (xb_ld(&bar[XB_TMO])) break; if (sp > XB_SPIN_CAP) { atomicAdd(&bar[XB_TMO], 1u); break; } }
    }
    nloc = mine > 0u ? mine : 1u; nx = cnt > 0u ? cnt : 1u;
}
__device__ __forceinline__ void xcd_barrier(const XcdBarrier& b) {
    asm volatile("s_waitcnt vmcnt(0)" ::: "memory");
    __syncthreads();
    if (threadIdx.x == 0) {
        unsigned* bar = b.bar;
        __builtin_amdgcn_s_waitcnt(0);
        unsigned nloc = b.st[0], nx = b.st[1];
        if (nloc == 0u) { xcd_barrier_complete(bar, b.x, nloc, nx); b.st[0] = nloc; b.st[1] = nx; }
        const unsigned old = xb_add(&bar[XB_XSUB(b.x)], 1u);
        const unsigned gen = old / nloc;
        if (old + 1u == (gen + 1u) * nloc) {
            __builtin_amdgcn_fence(__ATOMIC_RELEASE, "agent");
            asm volatile("s_waitcnt vmcnt(0)" ::: "memory");
            const unsigned og = xb_add(&bar[XB_TOP], 1u);
            const unsigned tg = og / nx;
            if (og + 1u == (tg + 1u) * nx) xb_add(&bar[XB_TOPGEN], 1u);
            else XB_SPIN(xb_ld(&bar[XB_TOPGEN]) == tg, bar);
            __builtin_amdgcn_fence(__ATOMIC_ACQUIRE, "agent");
            xb_add(&bar[XB_XGEN(b.x)], 1u);
            asm volatile("s_waitcnt vmcnt(0)" ::: "memory");
        } else {
            XB_SPIN(xb_ld(&bar[XB_XGEN(b.x)]) == gen, bar);
            __builtin_amdgcn_fence(__ATOMIC_ACQUIRE, "agent");
            asm volatile("s_waitcnt vmcnt(0)" ::: "memory");
        }
    }
    __syncthreads();
}

typedef unsigned short bf16;
using mk::bf2f; using mk::f2bf; using mk::cvt_pk_bf16; using mk::f32x4; using mk::u32x4; using mk::u32x2; using mk::Unit;

constexpr size_t al256(size_t v) { return (v + 255) & ~(size_t)255; }
constexpr size_t OFF_ACT = 0;
constexpr size_t OFF_MIX = OFF_ACT + al256((size_t)T * D * 2);
constexpr size_t OFF_BIG = OFF_MIX + al256((size_t)T * D * 2);
constexpr size_t OFF_WinT = OFF_BIG + al256((size_t)192 << 20);
constexpr size_t OFF_WoutT = OFF_WinT + al256((size_t)3072 * D * 2);
constexpr size_t OFF_WfT = OFF_WoutT + al256((size_t)D * D * 2);
constexpr size_t OFF_W13T = OFF_WfT + al256((size_t)D * D * 2);
constexpr size_t OFF_W2T = OFF_W13T + al256((size_t)64 * 512 * D * 2);
constexpr size_t OFF_DcT = OFF_W2T + al256((size_t)64 * D * HID * 2);
constexpr size_t OFF_CS = OFF_DcT + al256((size_t)4 * 512 * 256 * 2);
constexpr size_t OFF_rstd0 = OFF_CS + al256((size_t)2048 * 4096 * 2);
constexpr size_t OFF_rstd2 = OFF_rstd0 + al256((size_t)T * 4);
constexpr size_t OFF_dt = OFF_rstd2 + al256((size_t)T * 4);
constexpr size_t OFF_qkn = OFF_dt + al256((size_t)T * 16 * 4);
constexpr size_t OFF_WR = OFF_qkn + al256(512);
constexpr size_t OFF_LG = OFF_WR + al256((size_t)2 * 1024 * 36 * 4);
constexpr size_t OFF_cnt = OFF_LG + al256((size_t)T * 36 * 4);
constexpr size_t OFF_bar = OFF_cnt + al256(8192 + 256);
constexpr size_t OFF_list = OFF_bar + al256((size_t)XCD_BAR_WORDS * 4);
constexpr size_t OFF_TOT = OFF_list + al256((size_t)32 * CAP * 16);
constexpr size_t OFF_ccnt = OFF_TOT + al256((size_t)NB * 32 * 8 * 2 * 4);
constexpr size_t OFF_mids = OFF_ccnt + al256((size_t)256 * 64);
constexpr size_t WS_END = OFF_mids + al256((size_t)6 * 65536);
struct Params {
    const float *x, *norm_mix, *norm_ffn, *w_in, *q_norm, *k_norm, *lq1, *lk1, *lq2, *lk2, *subln, *conv_w, *conv_b,
        *dt_bias, *a_log, *d_skip, *ssd_norm, *w_out, *w_f, *rg_w, *rg_b, *re_w, *re_b, *w1, *w3, *w2;
    float* out;
    unsigned char* ws;
    __device__ __forceinline__ bf16* ACT() const { return (bf16*)(ws + OFF_ACT); }
    __device__ __forceinline__ bf16* MIX() const { return (bf16*)(ws + OFF_MIX); }
    __device__ __forceinline__ bf16* WinT() const { return (bf16*)(ws + OFF_WinT); }
    __device__ __forceinline__ bf16* WoutT() const { return (bf16*)(ws + OFF_WoutT); }
    __device__ __forceinline__ bf16* WfT() const { return (bf16*)(ws + OFF_WfT); }
    __device__ __forceinline__ bf16* W13T() const { return (bf16*)(ws + OFF_W13T); }
    __device__ __forceinline__ bf16* W2T() const { return (bf16*)(ws + OFF_W2T); }
    __device__ __forceinline__ bf16* DcT() const { return (bf16*)(ws + OFF_DcT); }
    __device__ __forceinline__ bf16* CS() const { return (bf16*)(ws + OFF_CS); }
    __device__ __forceinline__ float* rstd0() const { return (float*)(ws + OFF_rstd0); }
    __device__ __forceinline__ float* HMID(int k) const { return (float*)(ws + OFF_mids + (size_t)k * 65536); }
    __device__ __forceinline__ float* PMID(int k) const { return (float*)(ws + OFF_mids + (size_t)(3 + k) * 65536); }
    __device__ __forceinline__ bf16* X4(int a) const { return (bf16*)(ws + OFF_MIX + ((size_t)a << 24)); }
    __device__ __forceinline__ float* dt() const { return (float*)(ws + OFF_dt); }
    __device__ __forceinline__ float* qkn() const { return (float*)(ws + OFF_qkn); }
    __device__ __forceinline__ float* WR() const { return (float*)(ws + OFF_WR); }
    __device__ __forceinline__ float* LG() const { return (float*)(ws + OFF_LG); }
    __device__ __forceinline__ int* cnt() const { return (int*)(ws + OFF_cnt); }
    __device__ __forceinline__ unsigned* bar() const { return (unsigned*)(ws + OFF_bar); }
    __device__ __forceinline__ int4* list() const { return (int4*)(ws + OFF_list); }
    __device__ __forceinline__ float* TOT() const { return (float*)(ws + OFF_TOT); }
    __device__ __forceinline__ bf16* Qb() const { return (bf16*)(ws + OFF_BIG + 0); }
    __device__ __forceinline__ bf16* Kb() const { return (bf16*)(ws + OFF_BIG + (size_t)T * 512 * 2); }
    __device__ __forceinline__ bf16* Vb() const { return (bf16*)(ws + OFF_BIG + (size_t)T * 512 * 4); }
    __device__ __forceinline__ bf16* Zb() const { return (bf16*)(ws + OFF_BIG + (size_t)T * 512 * 6); }
    __device__ __forceinline__ bf16* XBC() const { return (bf16*)(ws + OFF_BIG + (size_t)T * 512 * 8); }
    __device__ __forceinline__ bf16* HID2() const { return (bf16*)(ws + OFF_BIG + 0); }
    __device__ __forceinline__ int* tok() const { return (int*)(ws + OFF_BIG + ((size_t)64 << 20)); }
    __device__ __forceinline__ int* ccnt() const { return (int*)(ws + OFF_ccnt); }
    __device__ __forceinline__ bf16* ZT() const { return (bf16*)(ws + OFF_BIG + 0); }
    __device__ __forceinline__ bf16* SLOC() const { return (bf16*)out; }
    __device__ __forceinline__ bf16* XC() const { return (bf16*)((unsigned char*)out + ((size_t)64 << 20)); }
};

__device__ __forceinline__ float silu_f(float v) { return v / (1.f + expf(-v)); }
__device__ __forceinline__ void unpack8(const u32x4 w, float (&f)[8]) {
    f[0] = __uint_as_float(w.x << 16); f[1] = __uint_as_float(w.x & 0xffff0000u); f[2] = __uint_as_float(w.y << 16); f[3] = __uint_as_float(w.y & 0xffff0000u);
    f[4] = __uint_as_float(w.z << 16); f[5] = __uint_as_float(w.z & 0xffff0000u); f[6] = __uint_as_float(w.w << 16); f[7] = __uint_as_float(w.w & 0xffff0000u);
}
__device__ __forceinline__ u32x4 pack8(const float (&f)[8]) { u32x4 o; o.x = cvt_pk_bf16(f[0], f[1]); o.y = cvt_pk_bf16(f[2], f[3]); o.z = cvt_pk_bf16(f[4], f[5]); o.w = cvt_pk_bf16(f[6], f[7]); return o; }

struct TItem { const float* src; const float* kscale; bf16* dst; int ldn, N, K, k0, n0; };
__device__ __forceinline__ void titem_load(const TItem& t, int tid, float4 (&v)[2], float (&sc)[2]) {
#pragma unroll
    for (int i = 0; i < 2; ++i) { const int k = (tid >> 4) + 32 * i, n4 = (tid & 15) * 4;
        v[i] = make_float4(0.f, 0.f, 0.f, 0.f); if (t.n0 + n4 < t.N) v[i] = *(const float4*)(t.src + (size_t)(t.k0 + k) * t.ldn + t.n0 + n4);
        sc[i] = t.kscale ? t.kscale[t.k0 + k] : 1.f; }
}
__device__ __forceinline__ void titem_lds(float* tile, int tid, const float4 (&v)[2], const float (&sc)[2]) {
#pragma unroll
    for (int i = 0; i < 2; ++i) { const int k = (tid >> 4) + 32 * i, n4 = (tid & 15) * 4; float* tp = tile + k * 65 + n4;
        tp[0] = v[i].x * sc[i]; tp[1] = v[i].y * sc[i]; tp[2] = v[i].z * sc[i]; tp[3] = v[i].w * sc[i]; }
}
__device__ __forceinline__ void titem_store(const TItem& t, const float* tile, int tid) {
    const int n = tid >> 3, k8 = (tid & 7) * 8; const float* tp = tile + k8 * 65 + n;
    u32x4 o; o.x = cvt_pk_bf16(tp[0 * 65], tp[1 * 65]); o.y = cvt_pk_bf16(tp[2 * 65], tp[3 * 65]); o.z = cvt_pk_bf16(tp[4 * 65], tp[5 * 65]); o.w = cvt_pk_bf16(tp[6 * 65], tp[7 * 65]);
    *(u32x4*)(t.dst + (size_t)(t.n0 + n) * t.K + t.k0 + k8) = o;
}
constexpr int TI_IN = 16 * 48, TI_O = 256, TI_F = 256, TI_13 = 32 * 128, TI_2 = 32 * 64, TI_SET0 = TI_IN + TI_O + TI_13, TI_SET1 = TI_2 + TI_F + TI_13, TI_SET2 = TI_2;
constexpr int TI_SET1_A = 5000;
template <class P> __device__ __forceinline__ void titem_w13(const P& p, int le, int q, TItem& t) {
    const int which = q >> 6, j = q & 63;
    t.src = (which ? p.w3 : p.w1) + (size_t)le * D * HID; t.ldn = HID; t.N = HID; t.K = D; t.kscale = p.norm_ffn + (le >> 5) * D;
    t.dst = p.W13T() + (size_t)le * 512 * D + (size_t)which * 256 * D; t.k0 = (j & 15) * 64; t.n0 = (j >> 4) * 64;
}
template <class P> __device__ __forceinline__ void titem_w2(const P& p, int le, int j, TItem& t) {
    t.src = p.w2 + (size_t)le * HID * D; t.ldn = D; t.N = D; t.K = HID; t.kscale = nullptr; t.dst = p.W2T() + (size_t)le * D * HID; t.k0 = (j & 3) * 64; t.n0 = (j >> 2) * 64;
}
template <class P> __device__ __forceinline__ void titem_decode(const P& p, int set, int it, TItem& t) {
    int r = it;
    if (set == 0) {
        if (r < TI_IN) { t.src = p.w_in; t.ldn = INC; t.N = INC; t.K = D; t.kscale = p.norm_mix; t.dst = p.WinT(); t.k0 = (r & 15) * 64; t.n0 = (r >> 4) * 64; return; } r -= TI_IN;
        if (r < TI_O) { t.src = p.w_out; t.ldn = D; t.N = D; t.K = D; t.kscale = nullptr; t.dst = p.WoutT(); t.k0 = (r & 15) * 64; t.n0 = (r >> 4) * 64; return; } r -= TI_O;
        titem_w13(p, r >> 7, r & 127, t); return;
    }
    if (set == 1) {
        if (r < TI_2) { titem_w2(p, r >> 6, r & 63, t); return; } r -= TI_2;
        if (r < TI_F) { t.src = p.w_f; t.ldn = D; t.N = D; t.K = D; t.kscale = nullptr; t.dst = p.WfT(); t.k0 = (r & 15) * 64; t.n0 = (r >> 4) * 64; return; } r -= TI_F;
        titem_w13(p, 32 + (r >> 7), r & 127, t); return;
    }
    titem_w2(p, 32 + (r >> 6), r & 63, t);
}
template <class P> __device__ __forceinline__ void titem_batch4(const P& p, int set, int it, int step, int n, float* sm, int tid) {
    TItem t0, t1, t2, t3; float4 v0[2], v1[2], v2[2], v3[2]; float c0[2], c1[2], c2[2], c3[2];
    const bool h1 = it + step < n, h2 = it + 2 * step < n, h3 = it + 3 * step < n;
    titem_decode(p, set, it, t0); titem_load(t0, tid, v0, c0);
    if (h1) { titem_decode(p, set, it + step, t1); titem_load(t1, tid, v1, c1); }
    if (h2) { titem_decode(p, set, it + 2 * step, t2); titem_load(t2, tid, v2, c2); }
    if (h3) { titem_decode(p, set, it + 3 * step, t3); titem_load(t3, tid, v3, c3); }
    titem_lds(sm, tid, v0, c0); if (h1) titem_lds(sm + 4160, tid, v1, c1); if (h2) titem_lds(sm + 8320, tid, v2, c2); if (h3) titem_lds(sm + 12480, tid, v3, c3);
    __syncthreads();
    titem_store(t0, sm, tid); if (h1) titem_store(t1, sm + 4160, tid); if (h2) titem_store(t2, sm + 8320, tid); if (h3) titem_store(t3, sm + 12480, tid);
    __syncthreads();
}
__device__ __forceinline__ void rows_to_bf16_rstd(const float* __restrict__ in, bf16* __restrict__ outb, float* __restrict__ rstd, int gw, int nw, int lane) {
    for (int r = gw; r < T; r += 2 * nw) {
        const int r2 = r + nw;
        const float4* ip = (const float4*)(in + (size_t)r * D); const float4* ip2 = (const float4*)(in + (size_t)(r2 < T ? r2 : r) * D);
        float4 v[4], v2[4];
#pragma unroll
        for (int i = 0; i < 4; ++i) { v[i] = ip[lane + i * 64]; v2[i] = ip2[lane + i * 64]; }
        float ss = 0.f, ss2 = 0.f;
#pragma unroll
        for (int i = 0; i < 4; ++i) { ss += v[i].x * v[i].x + v[i].y * v[i].y + v[i].z * v[i].z + v[i].w * v[i].w; ss2 += v2[i].x * v2[i].x + v2[i].y * v2[i].y + v2[i].z * v2[i].z + v2[i].w * v2[i].w; }
        ss = wave_sum(ss, lane); ss2 = wave_sum(ss2, lane);
        if (lane == 0) { rstd[r] = rsqrtf(ss * (1.f / D) + EPS); if (r2 < T) rstd[r2] = rsqrtf(ss2 * (1.f / D) + EPS); }
        u32x2* op = (u32x2*)(outb + (size_t)r * D);
#pragma unroll
        for (int i = 0; i < 4; ++i) { u32x2 o; o.x = cvt_pk_bf16(v[i].x, v[i].y); o.y = cvt_pk_bf16(v[i].z, v[i].w); op[lane + i * 64] = o; }
        if (r2 < T) { u32x2* op2 = (u32x2*)(outb + (size_t)r2 * D);
#pragma unroll
            for (int i = 0; i < 4; ++i) { u32x2 o; o.x = cvt_pk_bf16(v2[i].x, v2[i].y); o.y = cvt_pk_bf16(v2[i].z, v2[i].w); op2[lane + i * 64] = o; } }
    }
}

struct EpiInProj {
    typedef mk::BMapQK BMap;
    bf16* Qb; const float* rstd; const float* qkn; float* dt; const float* dt_bias;
    __device__ __forceinline__ void operator()(const f32x4 (&acc)[2][2][4][2], const Unit& u, int wr, int wc, int fr, int fq) const {
        const int row0 = u.pm * 256 + wr * 64 + fr, pn = u.pn;
        float rs[2][4];
#pragma unroll
        for (int ai = 0; ai < 2; ++ai)
#pragma unroll
            for (int m = 0; m < 4; ++m) rs[ai][m] = rstd[row0 + ai * 128 + m * 16];
        if (pn < 11) {
            bf16* dst = Qb + (size_t)(pn < 8 ? (pn >> 1) : 4) * T * 512;
            const int ld = pn < 8 ? 512 : 768;
            const int cbase = (pn < 8 ? (pn & 1) * 256 : (pn - 8) * 256) + wc * 64 + 8 * fq;
            f32x4 ww[2][2];
            { const float* w = qkn + (pn < 2 ? 0 : 64);
#pragma unroll
              for (int bj = 0; bj < 2; ++bj)
#pragma unroll
                for (int n = 0; n < 2; ++n) ww[bj][n] = pn < 4 ? *(const f32x4*)(w + 32 * bj + 8 * fq + 4 * n) : (f32x4){1.f, 1.f, 1.f, 1.f}; }
            const int ln = fq * 16 + fr;
#pragma unroll
            for (int ai = 0; ai < 2; ++ai)
#pragma unroll
                for (int m = 0; m < 4; ++m) {
                    const int row = row0 + ai * 128 + m * 16;
                    f32x4 v[2][2]; float ss = 0.f;
#pragma unroll
                    for (int bj = 0; bj < 2; ++bj)
#pragma unroll
                        for (int n = 0; n < 2; ++n) { v[bj][n] = acc[ai][bj][m][n] * rs[ai][m]; ss += v[bj][n][0] * v[bj][n][0] + v[bj][n][1] * v[bj][n][1] + v[bj][n][2] * v[bj][n][2] + v[bj][n][3] * v[bj][n][3]; }
                    float sc = 1.f;
                    if (pn < 4) { ss += shx(ss, 16, ln); ss += shx(ss, 32, ln); sc = rsqrtf(ss * (1.f / 64.f) + EPS); }
#pragma unroll
                    for (int bj = 0; bj < 2; ++bj) { const f32x4 v0 = v[bj][0] * sc * ww[bj][0], v1 = v[bj][1] * sc * ww[bj][1];
                        u32x4 o; o.x = cvt_pk_bf16(v0[0], v0[1]); o.y = cvt_pk_bf16(v0[2], v0[3]); o.z = cvt_pk_bf16(v1[0], v1[1]); o.w = cvt_pk_bf16(v1[2], v1[3]);
                        *(u32x4*)(dst + (size_t)row * ld + cbase + 32 * bj) = o; }
                }
        } else if (wc == 0 && fq < 2) {
            const f32x4 b0 = *(const f32x4*)(dt_bias + 8 * fq), b1 = *(const f32x4*)(dt_bias + 8 * fq + 4);
#pragma unroll
            for (int ai = 0; ai < 2; ++ai)
#pragma unroll
                for (int m = 0; m < 4; ++m) {
                    const int row = row0 + ai * 128 + m * 16;
                    f32x4 o0, o1;
#pragma unroll
                    for (int e = 0; e < 4; ++e) { const float x0 = acc[ai][0][m][0][e] * rs[ai][m] + b0[e], x1 = acc[ai][0][m][1][e] * rs[ai][m] + b1[e];
                        o0[e] = x0 > 20.f ? x0 : __logf(1.f + __expf(x0)); o1[e] = x1 > 20.f ? x1 : __logf(1.f + __expf(x1)); }
                    *(f32x4*)(dt + (size_t)row * 16 + 8 * fq) = o0; *(f32x4*)(dt + (size_t)row * 16 + 8 * fq + 4) = o1;
                }
        }
        __builtin_amdgcn_s_waitcnt(0x0F70);
    }
};
template <bool F32IN> struct EpiResid {
    typedef mk::BMapPerm BMap;
    const float* basef; bf16* X;
    __device__ __forceinline__ void operator()(const f32x4 (&acc)[2][2][4][2], const Unit& u, int wr, int wc, int fr, int fq) const {
        const int row0 = u.pm * 256 + wr * 64 + fr, col0 = u.pn * 256 + wc * 32 + 8 * fq;
#pragma unroll
        for (int ai = 0; ai < 2; ++ai) {
            f32x4 bf[4][2][2]; u32x4 bb[4][2];
#pragma unroll
            for (int m = 0; m < 4; ++m)
#pragma unroll
                for (int bj = 0; bj < 2; ++bj) { const size_t o = (size_t)(row0 + ai * 128 + m * 16) * D + col0 + bj * 128;
                    if (F32IN) { bf[m][bj][0] = *(const f32x4*)(basef + o); bf[m][bj][1] = *(const f32x4*)(basef + o + 4); } else bb[m][bj] = *(const u32x4*)(X + o); }
#pragma unroll
            for (int m = 0; m < 4; ++m)
#pragma unroll
                for (int bj = 0; bj < 2; ++bj) { const size_t o = (size_t)(row0 + ai * 128 + m * 16) * D + col0 + bj * 128; float v[8];
                    if (F32IN) { v[0] = bf[m][bj][0][0]; v[1] = bf[m][bj][0][1]; v[2] = bf[m][bj][0][2]; v[3] = bf[m][bj][0][3]; v[4] = bf[m][bj][1][0]; v[5] = bf[m][bj][1][1]; v[6] = bf[m][bj][1][2]; v[7] = bf[m][bj][1][3]; }
                    else unpack8(bb[m][bj], v);
#pragma unroll
                    for (int e = 0; e < 4; ++e) { v[e] += acc[ai][bj][m][0][e]; v[4 + e] += acc[ai][bj][m][1][e]; }
                    *(u32x4*)(X + o) = pack8(v); }
        }
    }
};
struct EpiChan {
    typedef mk::BMapPerm BMap;
    bf16* ZT;
    __device__ __forceinline__ void operator()(const f32x4 (&acc)[2][2][4][2], const Unit& u, int wr, int wc, int fr, int fq) const {
        const int bg = u.aux & 255, a = u.aux >> 8;
        bf16* Z = ZT + (size_t)bg * 256 * 2048 + a * 512 + u.pn * 256 + wc * 32 + 8 * fq;
#pragma unroll
        for (int ai = 0; ai < 2; ++ai)
#pragma unroll
            for (int m = 0; m < 4; ++m) {
                const int r = ai * 128 + wr * 64 + m * 16 + fr;
#pragma unroll
                for (int bj = 0; bj < 2; ++bj) { const f32x4 v0 = acc[ai][bj][m][0], v1 = acc[ai][bj][m][1];
                    u32x4 o; o.x = cvt_pk_bf16(v0[0], v0[1]); o.y = cvt_pk_bf16(v0[2], v0[3]); o.z = cvt_pk_bf16(v1[0], v1[1]); o.w = cvt_pk_bf16(v1[2], v1[3]);
                    *(u32x4*)(Z + (size_t)r * 2048 + bj * 128) = o; }
            }
    }
};
struct EpiSeq {
    typedef mk::BMapPerm BMap;
    bf16* F; const float* pmid; const float* p512; u32x4* park;
    __device__ __forceinline__ void operator()(const f32x4 (&acc)[2][2][4][2], const Unit& u, int wr, int wc, int fr, int fq) const {
        const int bg = u.aux & 255, part = (u.aux >> 8) & 1, cls = u.aux >> 9, b = bg >> 2, g = bg & 3;
        u32x4* pk = park + (size_t)blockIdx.x * 16 * 512 + (wr * 4 + wc) * 64 + fq * 16 + fr;
        constexpr float nrm = 0.0013810679320049757f;
        const float sg = (fr & 1) ? -nrm : nrm;
        if (part == 0) {
#pragma unroll
            for (int bj = 0; bj < 2; ++bj) {
                const int col = bj * 128 + wc * 32 + 8 * fq;
                const f32x4 pm0 = *(const f32x4*)(pmid + bg * 256 + col), pm1 = *(const f32x4*)(pmid + bg * 256 + col + 4), ph0 = *(const f32x4*)(p512 + bg * 256 + col), ph1 = *(const f32x4*)(p512 + bg * 256 + col + 4);
                const f32x4 m0 = cls ? pm0 * -nrm : pm0 * nrm + ph0 * sg, m1 = cls ? pm1 * -nrm : pm1 * nrm + ph1 * sg;
#pragma unroll
                for (int ai = 0; ai < 2; ++ai)
#pragma unroll
                    for (int m = 0; m < 4; ++m) {
                        const f32x4 v0 = acc[ai][bj][m][0] + m0, v1 = acc[ai][bj][m][1] + m1;
                        u32x4 o; o.x = cvt_pk_bf16(v0[0], v0[1]); o.y = cvt_pk_bf16(v0[2], v0[3]); o.z = cvt_pk_bf16(v1[0], v1[1]); o.w = cvt_pk_bf16(v1[2], v1[3]);
                        pk[((ai * 2 + bj) * 4 + m) * 512] = o;
                    }
            }
        } else {
            u32x4 uu[16];
#pragma unroll
            for (int i = 0; i < 16; ++i) uu[i] = pk[i * 512];
#pragma unroll
            for (int ai = 0; ai < 2; ++ai)
#pragma unroll
                for (int m = 0; m < 4; ++m) {
                    const int sp = 2 * (u.pm * 256 + ai * 128 + wr * 64 + m * 16 + fr) + cls;
#pragma unroll
                    for (int bj = 0; bj < 2; ++bj) {
                        float uv[8]; unpack8(uu[(ai * 2 + bj) * 4 + m], uv);
                        float lo[8], hi[8];
#pragma unroll
                        for (int e = 0; e < 4; ++e) { const float va = acc[ai][bj][m][0][e], vb = acc[ai][bj][m][1][e];
                            lo[e] = uv[e] - va; hi[e] = uv[e] + va; lo[4 + e] = uv[4 + e] - vb; hi[4 + e] = uv[4 + e] + vb; }
                        const int col = g * 256 + bj * 128 + wc * 32 + 8 * fq;
                        *(u32x4*)(F + (size_t)(b * SEQ + sp) * D + col) = pack8(lo);
                        if (sp != 0) *(u32x4*)(F + (size_t)(b * SEQ + 2048 - sp) * D + col) = pack8(hi);
                    }
                }
        }
    }
};

template <bool UP> struct SchedMoe {
    static constexpr bool GATHER = UP; static constexpr bool BJUMP = false;
    const MK_LAS int* tend; const MK_LAS int* tcnt;
    const int4* list; const char* A; const char* W; int nct;
    __device__ __forceinline__ bool next(int i, Unit& u) const {
        const int total = tend[31] * nct;
        const int L = i * gridDim.x + blockIdx.x; if (L >= total) return false;
        int flat; { const int q = total / 8, r = total % 8, xcd = L % 8, off = L / 8; flat = (xcd < r ? xcd * (q + 1) : r * (q + 1) + (xcd - r) * q) + off; }
        const int ln = (int)(threadIdx.x & 31);
        const unsigned long long bal = __ballot(flat >= tend[ln] * nct);
        const int e = __builtin_popcountll(bal) >> 1;
        const int prow = e ? tend[e - 1] : 0, c = tcnt[e];
        const int loc = flat - prow * nct, rt = loc / nct, ct = loc - rt * nct;
        u.pm = prow + rt; u.pn = ct; u.aux = e; u.nvalid = min(256, c - rt * 256); u.lst = list + e * CAP + rt * 256;
        if (UP) { u.a = A; u.b = W + ((size_t)e * 512 * D + (size_t)ct * 128 * D) * 2; }
        else { u.a = A + (size_t)u.pm * 256 * HID * 2; u.b = W + ((size_t)e * D * HID + (size_t)ct * 256 * HID) * 2; }
        return true;
    }
    __device__ __forceinline__ int arow(const Unit& u, int r) const { if (UP) return r < u.nvalid ? (u.lst[r].x >> 1) : 0; return r; }
};
__device__ __forceinline__ void moe_tables(const int* cnt, MK_LAS unsigned char* lds, int tid) {
    MK_LAS int* tend = (MK_LAS int*)(lds + 131072); MK_LAS int* tcnt = tend + 32;
    if (tid < 64) {
        const int ln = tid & 31; const int c = cnt[ln * 32]; int v = (c + 255) >> 8;
#pragma unroll
        for (int o = 1; o < 32; o <<= 1) { const int t = __builtin_amdgcn_ds_bpermute((tid - o) << 2, v); if (ln >= o) v += t; }
        if (tid < 32) { tend[ln] = v; tcnt[ln] = c; }
    }
    __syncthreads();
}
__device__ __forceinline__ void pair_tables(const int* ccnt, MK_LAS unsigned char* lds, int tid) {
    MK_LAS int* ctend = (MK_LAS int*)(lds + 131072 + 1024); MK_LAS int* ccount = ctend + 128; MK_LAS int* cpair = ccount + 128; MK_LAS int* cbase = cpair + 128;
    if (tid >= 64 && tid < 128) {
        const int ln = tid - 64, c0 = 2 * ln, c1 = c0 + 1;
        const int n0 = c0 < 112 ? ccnt[c0 * 16] : 0, n1 = c1 < 112 ? ccnt[c1 * 16] : 0;
        const int v0 = (n0 + 255) >> 8, v1 = (n1 + 255) >> 8; int v = v0 + v1;
#pragma unroll
        for (int o = 1; o < 64; o <<= 1) { const int t = __builtin_amdgcn_ds_bpermute((ln - o) << 2, v); if (ln >= o) v += t; }
        ctend[c0] = v - v1; ctend[c1] = v; ccount[c0] = n0; ccount[c1] = n1; cbase[c0] = v - v1 - v0; cbase[c1] = v - v1;
#pragma unroll
        for (int j = 0; j < 2; ++j) { const int c = c0 + j, gi = c / 28; int rem = c - gi * 28, lo = 0;
#pragma unroll
            for (int k = 0; k < 7; ++k) { if (rem >= 7 - lo) { rem -= 7 - lo; ++lo; } }
            cpair[c] = (gi * 8 + lo) | ((gi * 8 + lo + 1 + rem) << 8); }
    }
    __syncthreads();
}
struct SchedPair {
    static constexpr bool GATHER = false; static constexpr bool BJUMP = true;
    const MK_LAS int* ctend; const int* tok; const char* A; const char* W;
    __device__ __forceinline__ bool next(int i, Unit& u) const {
        const int total = ctend[127] * 4;
        const int L = i * gridDim.x + blockIdx.x; if (L >= total) return false;
        int flat; { const int q = total / 8, r = total % 8, xcd = L % 8, off = L / 8; flat = (xcd < r ? xcd * (q + 1) : r * (q + 1) + (xcd - r) * q) + off; }
        const int ln = (int)(threadIdx.x & 63);
        const int c = __builtin_popcountll(__ballot(flat >= ctend[ln] * 4)) + __builtin_popcountll(__ballot(flat >= ctend[64 + ln] * 4));
        const int prow = c ? ctend[c - 1] : 0, cc = ctend[128 + c], pr = ctend[256 + c], elo = pr & 255, ehi = pr >> 8;
        const int loc = flat - prow * 4, rt = loc >> 2, ct = loc & 3;
        u.pm = prow + rt; u.pn = ct; u.aux = c; u.nvalid = min(256, cc - rt * 256); u.lst = (const int4*)(tok + (size_t)u.pm * 256);
        u.a = A + (size_t)u.pm * 256 * 512 * 2; u.b = W + ((size_t)elo * D * HID + (size_t)ct * 256 * HID) * 2; u.bj = (ehi - elo) * (D * HID * 2) - 4 * 128;
        return true;
    }
    __device__ __forceinline__ int arow(const Unit&, int r) const { return r; }
};
struct EpiUp2 {
    typedef mk::BMapUp BMap;
    bf16* HID2; int* tok; const MK_LAS int* cbase;
    __device__ __forceinline__ void operator()(const f32x4 (&acc)[2][2][4][2], const Unit& u, int wr, int wc, int fr, int fq) const {
        float rs[2][4], gt[2][4]; int dr[2][4], tk[2][4];
#pragma unroll
        for (int ai = 0; ai < 2; ++ai)
#pragma unroll
            for (int m = 0; m < 4; ++m) { const int r = ai * 128 + wr * 64 + m * 16 + fr; const int4 e = u.lst[r];
                const bool ok = r < u.nvalid; const int c = (e.w >> 16) & 127;
                rs[ai][m] = __int_as_float(e.z); gt[ai][m] = __int_as_float(e.y); tk[ai][m] = e.x >> 1;
                dr[ai][m] = ok ? ((cbase[c] * 256 + (e.w & 0x7fff)) * 2 + ((e.w >> 24) & 1)) : -1; }
        const bool rec = u.pn == 0 && wc == 0 && fq == 0;
#pragma unroll
        for (int ai = 0; ai < 2; ++ai)
#pragma unroll
            for (int m = 0; m < 4; ++m) {
                if (dr[ai][m] >= 0) {
                    float h[8];
#pragma unroll
                    for (int n = 0; n < 2; ++n)
#pragma unroll
                        for (int e = 0; e < 4; ++e) { const float a1 = acc[ai][0][m][n][e] * rs[ai][m], a3 = acc[ai][1][m][n][e] * rs[ai][m]; h[4 * n + e] = a1 * __builtin_amdgcn_rcpf(1.f + __expf(-a1)) * a3 * gt[ai][m]; }
                    *(u32x4*)(HID2 + (size_t)(dr[ai][m] >> 1) * 512 + (dr[ai][m] & 1) * 256 + u.pn * 128 + wc * 32 + 8 * fq) = pack8(h);
                    if (rec && !(dr[ai][m] & 1)) tok[dr[ai][m] >> 1] = tk[ai][m];
                }
            }
    }
};
template <bool FINAL> struct EpiPair {
    typedef mk::BMapPerm BMap;
    bf16* X; float* out;
    __device__ __forceinline__ void operator()(const f32x4 (&acc)[2][2][4][2], const Unit& u, int wr, int wc, int fr, int fq) const {
        const int* tk = (const int*)u.lst; const int col0 = u.pn * 256 + wc * 32 + 8 * fq;
        int tv[2][4];
#pragma unroll
        for (int ai = 0; ai < 2; ++ai)
#pragma unroll
            for (int m = 0; m < 4; ++m) { const int r = ai * 128 + wr * 64 + m * 16 + fr; const int t = tk[r]; tv[ai][m] = r < u.nvalid ? t : -1; }
#pragma unroll
        for (int ai = 0; ai < 2; ++ai) {
            u32x4 bb[4][2];
#pragma unroll
            for (int m = 0; m < 4; ++m)
#pragma unroll
                for (int bj = 0; bj < 2; ++bj) bb[m][bj] = *(const u32x4*)(X + (size_t)(tv[ai][m] < 0 ? 0 : tv[ai][m]) * D + col0 + bj * 128);
#pragma unroll
            for (int m = 0; m < 4; ++m)
#pragma unroll
                for (int bj = 0; bj < 2; ++bj) {
                    if (tv[ai][m] >= 0) {
                        const size_t o = (size_t)tv[ai][m] * D + col0 + bj * 128; float v[8]; unpack8(bb[m][bj], v);
#pragma unroll
                        for (int e = 0; e < 4; ++e) { v[e] += acc[ai][bj][m][0][e]; v[4 + e] += acc[ai][bj][m][1][e]; }
                        if (FINAL) { *(f32x4*)(out + o) = (f32x4){v[0], v[1], v[2], v[3]}; *(f32x4*)(out + o + 4) = (f32x4){v[4], v[5], v[6], v[7]}; }
                        else *(u32x4*)(X + o) = pack8(v);
                    }
                }
        }
        __builtin_amdgcn_s_waitcnt(0x0F70);
    }
};
struct SchedChan {
    static constexpr bool GATHER = false; static constexpr bool BJUMP = false;
    const char* Dc; const char* X4;
    __device__ __forceinline__ bool next(int i, Unit& u) const {
        const int idx = i * gridDim.x + blockIdx.x; if (idx >= 512) return false;
        const int bg = idx >> 3, rem = idx & 7, a = rem >> 1, pn = rem & 1, b = bg >> 2, g = bg & 3;
        u.a = Dc + (size_t)((g * 2 + (a >> 1)) * 256) * 256 * 2; u.b = X4 + ((size_t)a << 24) + ((size_t)(b * 512 + pn * 256) * D + g * 256) * 2;
        u.pm = 0; u.pn = pn; u.aux = bg | (a << 8); u.nvalid = 256; u.lst = nullptr; return true;
    }
    __device__ __forceinline__ int arow(const Unit&, int r) const { return r; }
};
struct SchedSeq {
    static constexpr bool GATHER = false; static constexpr bool BJUMP = false;
    const char* CS; const char* ZT;
    __device__ __forceinline__ bool next(int i, Unit& u) const {
        const int tile = blockIdx.x + (i >> 1) * gridDim.x, part = i & 1; if (tile >= 256) return false;
        const int pm = tile & 1, cls = (tile >> 1) & 1, bg = tile >> 2, a = part ? 3 - cls : cls;
        u.a = CS + (size_t)((part * 2 + cls) * 512 + pm * 256) * 512 * 2; u.b = ZT + ((size_t)bg * 256 * 2048 + a * 512) * 2;
        u.pm = pm; u.pn = 0; u.aux = bg | (part << 8) | (cls << 9); u.nvalid = 256; u.lst = nullptr; return true;
    }
    __device__ __forceinline__ int arow(const Unit&, int r) const { return r; }
};

__device__ __forceinline__ void moe_router(const Params& p, int l, MK_LAS unsigned char* lds, int tid, int gw, int nw) {
    typedef short bfx8 __attribute__((ext_vector_type(8)));
    {
        const u32x4* src = (const u32x4*)((const bf16*)p.WR() + (size_t)l * 2 * 36864);
#pragma unroll
        for (int i = 0; i < 18; ++i) *(MK_LAS u32x4*)(lds + (tid + i * 512) * 16) = src[tid + i * 512];
        if (tid < 32) *(MK_LAS int*)(lds + 147456 + tid * 4) = 0;
        if (tid < 128) *(MK_LAS int*)(lds + 147456 + 256 + tid * 4) = 0;
        __syncthreads();
    }
    const int lane = tid & 63, r = lane & 15, q = lane >> 4;
    const float* rgb = p.rg_b + l * 4; const float* reb = p.re_b + l * 32;
    const MK_LAS bfx8* w01 = (const MK_LAS bfx8*)lds + (q * 2) * 16 + r;
    const MK_LAS bfx8* w2 = (const MK_LAS bfx8*)(lds + 65536) + q * 4 + (r & 3);
    for (int t0 = blockIdx.x * 8; t0 < T / 16; t0 += gridDim.x * 8) {
        const int tile = t0 + (tid >> 6);
        const bfx8* xr = (const bfx8*)(p.ACT() + (size_t)(tile * 16 + r) * D + 8 * q);
        f32x4 acc0 = {0.f, 0.f, 0.f, 0.f}, acc1 = acc0, acc2 = acc0, accs = acc0;
        bfx8 xa[32];
#pragma unroll
        for (int ks = 0; ks < 32; ++ks) xa[ks] = xr[ks * 4];
#pragma unroll
        for (int ks = 0; ks < 32; ++ks) {
            const bfx8 a = xa[ks];
            const bfx8 h0 = w01[ks * 128], h1 = w01[ks * 128 + 16], h2 = w2[ks * 16], l0 = w01[4608 + ks * 128], l1 = w01[4608 + ks * 128 + 16], l2 = w2[4608 + ks * 16];
            acc0 = __builtin_amdgcn_mfma_f32_16x16x32_bf16(a, h0, acc0, 0, 0, 0); acc1 = __builtin_amdgcn_mfma_f32_16x16x32_bf16(a, h1, acc1, 0, 0, 0); acc2 = __builtin_amdgcn_mfma_f32_16x16x32_bf16(a, h2, acc2, 0, 0, 0);
            acc0 = __builtin_amdgcn_mfma_f32_16x16x32_bf16(a, l0, acc0, 0, 0, 0); acc1 = __builtin_amdgcn_mfma_f32_16x16x32_bf16(a, l1, acc1, 0, 0, 0); acc2 = __builtin_amdgcn_mfma_f32_16x16x32_bf16(a, l2, acc2, 0, 0, 0);
            accs = __builtin_amdgcn_mfma_f32_16x16x32_bf16(a, a, accs, 0, 0, 0);
        }
        float ss;
        { const float d = (r & 3) == 0 ? accs[0] : (r & 3) == 1 ? accs[1] : (r & 3) == 2 ? accs[2] : accs[3];
          ss = shidx(d, (r >> 2) * 16 + r); }
        float* lg = p.LG() + (size_t)tile * 16 * 36;
#pragma unroll
        for (int g4 = 0; g4 < 4; ++g4) { lg[(4 * q + g4) * 36 + r] = acc0[g4]; lg[(4 * q + g4) * 36 + 16 + r] = acc1[g4]; if (r < 4) lg[(4 * q + g4) * 36 + 32 + r] = acc2[g4]; }
        asm volatile("s_waitcnt vmcnt(0)" ::: "memory");
        int E0 = 0, E1 = 0, pos0 = 0, pos1 = 0, cls = 0, cpos = 0, sl0 = 0; float gt0 = 0.f, gt1 = 0.f, rs = 0.f;
        MK_LAS int* lcnt = (MK_LAS int*)(lds + 147456); MK_LAS int* lbase = lcnt + 32; MK_LAS int* lcc = lcnt + 64; MK_LAS int* lcb = lcc + 128;
        if (lane < 16) {
            rs = rsqrtf(ss * (1.f / D) + EPS);
            const f32x4* lv = (const f32x4*)(lg + lane * 36);
            float raw[36];
#pragma unroll
            for (int i = 0; i < 9; ++i) { const f32x4 v = lv[i]; raw[4 * i] = v[0]; raw[4 * i + 1] = v[1]; raw[4 * i + 2] = v[2]; raw[4 * i + 3] = v[3]; }
            float gl[4];
#pragma unroll
            for (int c = 0; c < 4; ++c) gl[c] = raw[c] * rs + rgb[c];
            int gi = 0; float gm = gl[0];
#pragma unroll
            for (int c = 1; c < 4; ++c) if (gl[c] > gm) { gm = gl[c]; gi = c; }
            float gs = 0.f;
#pragma unroll
            for (int c = 0; c < 4; ++c) gs += expf(gl[c] - gm);
            const float g_p = 1.f / gs;
            float el[8];
#pragma unroll
            for (int e = 0; e < 8; ++e) { const float v = gi == 0 ? raw[4 + e] : gi == 1 ? raw[12 + e] : gi == 2 ? raw[20 + e] : raw[28 + e]; el[e] = v * rs + reb[gi * 8 + e]; }
            int e0 = 0; float m0 = el[0];
#pragma unroll
            for (int e = 1; e < 8; ++e) if (el[e] > m0) { m0 = el[e]; e0 = e; }
            int e1 = -1; float m1 = -3.4e38f;
#pragma unroll
            for (int e = 0; e < 8; ++e) if (e != e0 && el[e] > m1) { m1 = el[e]; e1 = e; }
            const float rr = expf(m1 - m0);
            gt0 = g_p / (1.f + rr); gt1 = g_p * rr / (1.f + rr);
            E0 = gi * 8 + e0; E1 = gi * 8 + e1;
            pos0 = __hip_atomic_fetch_add(lcnt + E0, 1, __ATOMIC_RELAXED, __HIP_MEMORY_SCOPE_WORKGROUP);
            pos1 = __hip_atomic_fetch_add(lcnt + E1, 1, __ATOMIC_RELAXED, __HIP_MEMORY_SCOPE_WORKGROUP);
            { const int lo = e0 < e1 ? e0 : e1, hi = e0 < e1 ? e1 : e0; cls = gi * 28 + ((lo * (15 - lo)) >> 1) + hi - lo - 1; sl0 = e0 > e1 ? 1 : 0; }
            cpos = __hip_atomic_fetch_add(lcc + cls, 1, __ATOMIC_RELAXED, __HIP_MEMORY_SCOPE_WORKGROUP);
        }
        __syncthreads();
        if (tid < 32) { const int n = lcnt[tid]; lbase[tid] = n ? atomicAdd(&p.cnt()[(l * 32 + tid) * 32], n) : 0; }
        if (tid >= 64 && tid < 192) { const int c = tid - 64, n = lcc[c]; lcb[c] = n ? atomicAdd(&p.ccnt()[(l * 128 + c) * 16], n) : 0; }
        __syncthreads();
        if (lane < 16) {
            const int t = tile * 16 + lane;
            const int w = (cls << 16) | (lcb[cls] + cpos);
            p.list()[E0 * CAP + lbase[E0] + pos0] = make_int4(t * 2, __float_as_int(gt0), __float_as_int(rs), w | (sl0 << 24));
            p.list()[E1 * CAP + lbase[E1] + pos1] = make_int4(t * 2 + 1, __float_as_int(gt1), __float_as_int(rs), w | ((1 - sl0) << 24));
        }
        __syncthreads();
        if (tid < 32) lcnt[tid] = 0;
        if (tid >= 64 && tid < 192) lcc[tid - 64] = 0;
        __syncthreads();
    }
    __syncthreads();
}
__device__ __forceinline__ float row_sq(const u32x4 (&x)[2], float (&w)[16]) {
    float ss = 0.f;
#pragma unroll
    for (int i = 0; i < 2; ++i) { float q[8]; unpack8(x[i], q);
#pragma unroll
        for (int j = 0; j < 8; ++j) { w[i * 8 + j] = q[j]; ss += q[j] * q[j]; } }
    return ss;
}
__device__ __forceinline__ void row16(const Params& p, int t, int lane, float (&w)[16], float& rs) {
    u32x4 x[2];
#pragma unroll
    for (int i = 0; i < 2; ++i) x[i] = *(const u32x4*)(p.ACT() + (size_t)t * D + lane * 8 + i * 512);
    rs = rsqrtf(wave_sum(row_sq(x, w), lane) * (1.f / D) + EPS);
}
__device__ __forceinline__ void mid_store(float* o, const float (&v)[16], int lane) {
#pragma unroll
    for (int i = 0; i < 2; ++i) { float* q = o + lane * 8 + i * 512;
        *(float4*)q = make_float4(v[i * 8], v[i * 8 + 1], v[i * 8 + 2], v[i * 8 + 3]); *(float4*)(q + 4) = make_float4(v[i * 8 + 4], v[i * 8 + 5], v[i * 8 + 6], v[i * 8 + 7]); }
}
__device__ __forceinline__ void moe_fold(const Params& p, int gw, int nw, int lane) {
    for (int task = gw; task < NB * 513; task += nw) {
        const int b = task < NB * 512 ? (task >> 9) : task - NB * 512, s = task < NB * 512 ? (task & 511) : 512;
        float w1[16], w2[16], r1, r2;
        if (s == 0 || s == 512) {
            row16(p, b * SEQ + (s ? 512 : 0), lane, w1, r1); row16(p, b * SEQ + (s ? 1536 : 1024), lane, w2, r2);
            float e[16], o[16];
#pragma unroll
            for (int j = 0; j < 16; ++j) { const float a = w1[j] * r1, c = w2[j] * r2; e[j] = s ? a + c : c; o[j] = s ? a - c : a; }
            if (s) { mid_store(p.HMID(1) + b * D, e, lane);
#pragma unroll
                for (int i = 0; i < 2; ++i) { float h0[8];
#pragma unroll
                    for (int j = 0; j < 8; ++j) h0[j] = o[i * 8 + j];
                    *(u32x4*)(p.X4(2) + ((size_t)b * 512) * D + lane * 8 + i * 512) = pack8(h0); } }
            else {
                mid_store(p.HMID(0) + b * D, e, lane);
#pragma unroll
                for (int i = 0; i < 2; ++i) { const size_t off = ((size_t)b * 512) * D + lane * 8 + i * 512; float h0[8];
#pragma unroll
                    for (int j = 0; j < 8; ++j) h0[j] = o[i * 8 + j];
                    const u32x4 pk = pack8(h0), z = {0u, 0u, 0u, 0u};
                    *(u32x4*)(p.X4(0) + off) = pk; *(u32x4*)(p.X4(1) + off) = pk; *(u32x4*)(p.X4(3) + off) = z; }
            }
            continue;
        }
        float w3[16], w4[16], r3, r4;
        row16(p, b * SEQ + s, lane, w1, r1); row16(p, b * SEQ + 1024 - s, lane, w2, r2); row16(p, b * SEQ + 1024 + s, lane, w3, r3); row16(p, b * SEQ + 2048 - s, lane, w4, r4);
#pragma unroll
        for (int i = 0; i < 2; ++i) {
            float ee[8], eo[8], oe[8], oo[8];
#pragma unroll
            for (int j = 0; j < 8; ++j) { const float h1 = w1[i * 8 + j] * r1, h2 = w2[i * 8 + j] * r2, h3 = w3[i * 8 + j] * r3, h4 = w4[i * 8 + j] * r4;
                const float e1 = h1 + h4, e2 = h2 + h3, o1 = h1 - h4, o2 = h2 - h3;
                ee[j] = e1 + e2; eo[j] = e1 - e2; oe[j] = o1 + o2; oo[j] = o1 - o2; }
            const size_t off = ((size_t)b * 512 + s) * D + lane * 8 + i * 512;
            *(u32x4*)(p.X4(0) + off) = pack8(ee); *(u32x4*)(p.X4(1) + off) = pack8(eo); *(u32x4*)(p.X4(2) + off) = pack8(oe); *(u32x4*)(p.X4(3) + off) = pack8(oo);
        }
    }
}
__device__ __forceinline__ void run_phase(const Params& p, int ph, float* sm, MK_LAS unsigned char* lds) {
    int tid = threadIdx.x; asm volatile("" : "+v"(tid));
    const int lane = tid & 63;
    const int gtid = blockIdx.x * blockDim.x + tid, gthreads = gridDim.x * blockDim.x;
    const int gw = gtid >> 6, nw = gthreads >> 6;
    switch (ph) {
    case 0: {
        if (blockIdx.x == 0 && tid < 64) { p.cnt()[tid * 32] = 0; if (tid == 0) { p.cnt()[64 * 32] = 0; p.cnt()[65 * 32] = 0; p.cnt()[64 * 32 + 8] = 0; p.cnt()[64 * 32 + 16] = 0; } p.qkn()[tid] = p.q_norm[tid] * at::C2; p.qkn()[64 + tid] = p.k_norm[tid];        }
        if (blockIdx.x == 1 && tid < 256) p.ccnt()[tid * 16] = 0;
        rows_to_bf16_rstd(p.x, p.ACT(), p.rstd0(), gw, nw, lane);
        for (int it = blockIdx.x; it < TI_SET0; it += 4 * gridDim.x) titem_batch4(p, 0, it, (int)gridDim.x, TI_SET0, sm, tid);
        for (int i = gtid; i < 2 * 1024 * 36; i += gthreads) { const int l = i / (1024 * 36), r = i - l * 1024 * 36, k = r / 36, c = r - k * 36;
            const float v = p.norm_ffn[l * D + k] * (c < 4 ? p.rg_w[((size_t)l * D + k) * 4 + c] : p.re_w[((size_t)l * D + k) * 32 + c - 4]);
            const bf16 hi = f2bf(v), lo = f2bf(v - bf2f(hi));
            const int ks = k >> 5, q = (k >> 3) & 3, j = k & 7;
            const int idx = c < 32 ? ((((ks * 4 + q) * 2 + (c >> 4)) * 16 + (c & 15)) * 8 + j) : (32768 + (((ks * 4 + q) * 4 + (c - 32)) * 8 + j));
            bf16* img = (bf16*)p.WR() + (size_t)l * 2 * 36864;
            img[idx] = hi; img[36864 + idx] = lo; }
        const float* w2n = p.norm_mix + D;
        for (int i = gtid; i < 4 * 2 * 256 * 256; i += gthreads) {
            const int g = i >> 17, part = (i >> 16) & 1, co = (i >> 8) & 255, ch = i & 255;
            const float ang = 2.f * (float)((ch * co) & 255) * (1.f / 256.f);
            p.DcT()[i] = f2bf(w2n[g * 256 + ch] * (part ? __builtin_amdgcn_sinf(0.5f * ang) : __builtin_amdgcn_cosf(0.5f * ang)));
        }
        const float nrm = 1.f / sqrtf(2048.f * 256.f);
        for (int i = gtid; i < 4 * 512 * 64; i += gthreads) {
            const int mat = i >> 15, m = (i >> 6) & 511, k8 = (i & 63) * 8, sp = 2 * m + (mat & 1), part = mat >> 1;
            float v[8];
#pragma unroll
            for (int j = 0; j < 8; ++j) { const float turns = (float)((sp * (k8 + j)) & 2047) * (1.f / 2048.f); v[j] = nrm * (part ? __builtin_amdgcn_sinf(turns) : __builtin_amdgcn_cosf(turns)); }
            if (mat == 3 && k8 == 0) v[0] = (m & 1) ? -nrm : nrm;
            *(u32x4*)(p.CS() + ((size_t)mat * 512 + m) * 512 + k8) = pack8(v);
        }
    } break;
    case 1: {
        mk::SchedGrid S; S.A = (const char*)p.ACT(); S.Bt = (const char*)p.WinT(); S.nM = T / 256; S.nN = 12; S.lda = D; S.ldb = D;
        EpiInProj E; E.Qb = p.Qb(); E.rstd = p.rstd0(); E.qkn = p.qkn(); E.dt = p.dt(); E.dt_bias = p.dt_bias;
        mk::gemm_phase(lds, D, D, D, S, E);
    } break;
    case 3: {
        float a1 = p.lq1[lane] * p.lk1[lane], a2 = p.lq2[lane] * p.lk2[lane];
        a1 = wave_sum(a1, lane); a2 = wave_sum(a2, lane);
        const float lam_init = 0.2f;
        const float lam = expf(a1) - expf(a2) + lam_init;
        char* ldsg = (char*)sm;
        float smax;
        { float gq = fabsf(p.qkn()[lane]), gk = fabsf(p.qkn()[64 + lane]);
#pragma unroll
          for (int o_ = 32; o_ > 0; o_ >>= 1) { gq = fmaxf(gq, shx(gq, o_, lane)); gk = fmaxf(gk, shx(gk, o_, lane)); }
          smax = 64.f * gq * gk * 1.02f + 0.5f; }
        for (int idx = blockIdx.x; idx < NB * 4 * 8; idx += gridDim.x) {
            int bh = (idx & 7) + 8 * (idx >> 6); if (idx >= (int)gridDim.x) bh ^= 3;
            const int qb = (idx >> 3) & 7, b = bh >> 2, h = bh & 3;
            const float sl2 = exp2f(-2.f * (float)(h + 1)) * 1.4426950408889634f;
            int jlo, ntl;
            { const float df = (smax + 160.f) / sl2; const int dmax = df < 4096.f ? (int)df + 1 : 4096;
              const int klo = max(0, qb * 256 - dmax), khi = min(SEQ - 1, qb * 256 + 255 + dmax);
              jlo = klo >> 6; int jhi = (khi >> 6) + 1;
              if ((jhi - jlo) & 1) { if (jlo > 0) --jlo; else ++jhi; }
              if (jhi - jlo < 4) { jlo = 0; jhi = SEQ / at::KVBLK; }
              jlo = __builtin_amdgcn_readfirstlane(jlo); ntl = __builtin_amdgcn_readfirstlane(jhi - jlo); }
            const bf16* Kh = p.Kb() + (size_t)b * SEQ * 512 + h * 128;
            const bf16* Vh = p.Vb() + (size_t)b * SEQ * 512 + h * 128;
            at::f32x16 o[4]; float l1, l0;
            {
                int tu = threadIdx.x; asm volatile("" : "+v"(tu));
                const int wid = tu >> 6, r32 = tu & 31, hi = (tu >> 5) & 1, qrow = qb * 256 + wid * 32 + r32;
                float* ws = (float*)(ldsg + 2 * at::SHM_V + 2 * at::SHM_K) + wid * 64;
                const bf16* Qw = p.Qb() + ((size_t)b * SEQ + qrow) * 512 + h * 128 + hi * 8;
                at::attn_pass(Qw, Kh, Vh, o, l0, ws, qrow, sl2, ldsg, tu, jlo, ntl);
                unsigned* park = (unsigned*)(ldsg + 53248) + tu;
#pragma unroll
                for (int d = 0; d < 4; ++d)
#pragma unroll
                    for (int r = 0; r < 8; ++r) park[(d * 8 + r) * 512] = at::cvtpk(o[d][2 * r], o[d][2 * r + 1]);
            }
            {
                int tu = threadIdx.x; asm volatile("" : "+v"(tu));
                const int wid = tu >> 6, r32 = tu & 31, hi = (tu >> 5) & 1, qrow = qb * 256 + wid * 32 + r32;
                float* ws = (float*)(ldsg + 2 * at::SHM_V + 2 * at::SHM_K) + wid * 64;
                const bf16* Qw = p.Qb() + ((size_t)b * SEQ + qrow) * 512 + h * 128 + 64 + hi * 8;
                at::attn_pass(Qw, Kh + 64, Vh, o, l1, ws, qrow, sl2, ldsg, tu, jlo, ntl);
            }
            {
                int tu = threadIdx.x; asm volatile("" : "+v"(tu));
                const int wid = tu >> 6, r32 = tu & 31, hi = (tu >> 5) & 1;
                float* ws = (float*)(ldsg + 2 * at::SHM_V + 2 * at::SHM_K) + wid * 64;
                const unsigned* park = (const unsigned*)(ldsg + 53248) + tu;
                if (hi == 0) { ws[r32] = 1.f / l0; ws[32 + r32] = lam / l1; }
                asm volatile("s_waitcnt lgkmcnt(0)" ::: "memory");
                float ssq[16];
#pragma unroll
                for (int r = 0; r < 16; ++r) { const int cr = at::crow(r, hi); const float i0 = ws[cr], i1 = ws[32 + cr]; float q = 0.f;
#pragma unroll
                    for (int d = 0; d < 4; ++d) { const unsigned w = park[(d * 8 + (r >> 1)) * 512]; const float o0 = __uint_as_float((r & 1) ? (w & 0xffff0000u) : (w << 16));
                        const float v = o0 * i0 - o[d][r] * i1; o[d][r] = v; q += v * v; }
                    ssq[r] = q; }
#pragma unroll
                for (int r = 0; r < 16; ++r) { float q = ssq[r]; { const int ln = tu & 63; q += shx(q, 1, ln); q += shx(q, 2, ln); q += shx(q, 4, ln); q += shx(q, 8, ln); q += shx(q, 16, ln); }
                    ssq[r] = rsqrtf(q * (1.f / 128.f) + EPS) * (1.f - lam_init); }
                bf16* pr = p.MIX() + ((size_t)b * SEQ + qb * 256 + wid * 32 + 4 * hi) * D + h * 128 + r32;
                const float w0 = p.subln[r32], w1 = p.subln[32 + r32], w2 = p.subln[64 + r32], w3 = p.subln[96 + r32];
#pragma unroll
                for (int r = 0; r < 16; ++r) {
                    asm volatile("" : "+v"(pr));
                    pr[0] = f2bf(o[0][r] * ssq[r] * w0); pr[32] = f2bf(o[1][r] * ssq[r] * w1); pr[64] = f2bf(o[2][r] * ssq[r] * w2); pr[96] = f2bf(o[3][r] * ssq[r] * w3);
                    pr += ((r & 3) == 3 ? 5 : 1) * D;
                }
                asm volatile("s_waitcnt lgkmcnt(0)" ::: "memory");
                __syncthreads();
            }
        }
        { MK_LAS int* slotw = (MK_LAS int*)(lds + 131072 + 512);
          for (;;) {
              __syncthreads();
              if (tid == 0) *slotw = atomicAdd(&p.cnt()[64 * 32 + 16], 1);
              __syncthreads();
              const int u = *slotw; if (u >= NB * 32) break;
              sd::s1_unit(p.XBC(), p.conv_w, p.conv_b, p.dt(), p.a_log, p.SLOC(), p.TOT(), u, (char*)sm);
          } }
    } break;
    case 5: sd::s2_scan(p.SLOC(), p.TOT(), gtid, gthreads); break;
    case 6: {
        for (int u = blockIdx.x; u < NB * 32; u += gridDim.x) sd::s3_unit(p.XBC(), p.conv_w, p.conv_b, p.dt(), p.a_log, p.d_skip, p.SLOC(), p.Zb(), p.ssd_norm, p.MIX(), u, (char*)sm);
    } break;
    case 7: {
        mk::SchedGrid S; S.A = (const char*)p.MIX(); S.Bt = (const char*)p.WoutT(); S.nM = T / 256; S.nN = 4; S.lda = D; S.ldb = D;
        EpiResid<false> E; E.basef = nullptr; E.X = p.ACT();
        mk::gemm_phase(lds, D, D, D, S, E);
    } break;
    case 8: moe_router(p, 0, lds, tid, gw, nw); break;
    case 9: case 16: {
        const int l = ph == 9 ? 0 : 1;
        moe_tables(p.cnt() + l * 32 * 32, lds, tid);
        SchedMoe<true> S; S.tend = (const MK_LAS int*)(lds + 131072); S.tcnt = S.tend + 32; S.list = p.list(); S.A = (const char*)p.ACT(); S.W = (const char*)(p.W13T() + (size_t)l * 32 * 512 * D); S.nct = 2;
        pair_tables(p.ccnt() + l * 128 * 16, lds, tid);
        EpiUp2 E; E.HID2 = p.HID2(); E.tok = p.tok(); E.cbase = (const MK_LAS int*)(lds + 131072 + 1024) + 384;
        mk::gemm_phase(lds, D, D, D, S, E);
        {
            MK_LAS int* slotw = (MK_LAS int*)(lds + 131072 + 512);
            const int nset = l == 0 ? TI_SET1 : TI_SET2, ncap = l == 0 ? TI_SET1_A : TI_SET2;
            for (;;) {
                __syncthreads();
                if (tid == 0) *slotw = atomicAdd(&p.cnt()[(64 + l) * 32], 4);
                __syncthreads();
                const int it = *slotw; if (it >= ncap) break;
                titem_batch4(p, 1 + l, it, 1, nset, sm, tid);
            }
        }
    } break;
    case 10: case 17: {
        const int l = ph == 10 ? 0 : 1;
        {
            pair_tables(p.ccnt() + l * 128 * 16, lds, tid);
            SchedPair S; S.ctend = (const MK_LAS int*)(lds + 131072 + 1024); S.tok = p.tok(); S.A = (const char*)p.HID2(); S.W = (const char*)(p.W2T() + (size_t)l * 32 * D * HID);
            if (l == 1) { EpiPair<true> E; E.X = p.ACT(); E.out = p.out; mk::gemm_phase(lds, 2 * HID, 2 * HID, HID, S, E); }
            else { EpiPair<false> E; E.X = p.ACT(); E.out = nullptr; mk::gemm_phase(lds, 2 * HID, 2 * HID, HID, S, E);
                MK_LAS int* slotw = (MK_LAS int*)(lds + 131072 + 512);
                for (;;) {
                    __syncthreads();
                    if (tid == 0) *slotw = atomicAdd(&p.cnt()[64 * 32 + 8], 4);
                    __syncthreads();
                    const int it = TI_SET1_A + *slotw; if (it >= TI_SET1) break;
                    titem_batch4(p, 1, it, 1, TI_SET1, sm, tid);
                } }
            break;
        }
    } break;
    case 11: moe_fold(p, gw, nw, lane); break;
    case 12: {
        {
            const int i = gtid >> 3, part = gtid & 7;
            if (i < 64 * 256) {
                const int bg = i >> 8, c = i & 255, b = bg >> 2, g = bg & 3;
#pragma unroll 1
                for (int k = 0; k < 2; ++k) {
                    const float* hm = p.HMID(k) + b * D + g * 256 + part * 32; const bf16* dc = p.DcT() + ((size_t)(g * 2) * 256 + c) * 256 + part * 32;
                    u32x4 dv[4]; f32x4 hv[8];
#pragma unroll
                    for (int q = 0; q < 4; ++q) dv[q] = *(const u32x4*)(dc + q * 8);
#pragma unroll
                    for (int q = 0; q < 8; ++q) hv[q] = *(const f32x4*)(hm + q * 4);
                    float a = 0.f;
#pragma unroll
                    for (int q = 0; q < 4; ++q) { float f[8]; unpack8(dv[q], f);
#pragma unroll
                        for (int j = 0; j < 4; ++j) { a = fmaf(hv[2 * q][j], f[j], a); a = fmaf(hv[2 * q + 1][j], f[4 + j], a); } }
                    a += shx(a, 1, lane); a += shx(a, 2, lane); a += shx(a, 4, lane);
                    if (part == 0) p.PMID(k)[i] = a;
                }
            }
        }
        SchedChan S; S.Dc = (const char*)p.DcT(); S.X4 = (const char*)p.X4(0);
        EpiChan E; E.ZT = p.ZT();
        mk::gemm_phase(lds, 256, 256, D, S, E);
    } break;
    case 13: {
        {
            const int i = gtid >> 3, part = gtid & 7;
            if (i < 64 * 256) {
                const int bg = i >> 8, c = i & 255, b = bg >> 2, g = bg & 3;
                const bf16* z = p.ZT() + ((size_t)bg * 256 + c) * 2048 + part * 64;
                u32x4 zv[8];
#pragma unroll
                for (int k = 0; k < 8; ++k) zv[k] = *(const u32x4*)(z + k * 8);
                float a = 0.f;
#pragma unroll
                for (int k = 0; k < 8; ++k) { float f[8]; unpack8(zv[k], f); a += (f[0] - f[1]) + (f[2] - f[3]) + (f[4] - f[5]) + (f[6] - f[7]); }
                a += shx(a, 1, lane); a += shx(a, 2, lane); a += shx(a, 4, lane);
                if (part == 0) p.MIX()[(size_t)(b * SEQ + 1024) * D + g * 256 + c] = f2bf(0.0013810679320049757f * (a + p.PMID(1)[i] + p.PMID(0)[i]));
            }
        }
        SchedSeq S; S.CS = (const char*)p.CS(); S.ZT = (const char*)p.ZT();
        EpiSeq E; E.F = p.MIX(); E.pmid = p.PMID(0); E.p512 = p.PMID(1); E.park = (u32x4*)((unsigned char*)p.ZT() + ((size_t)64 << 20));
        mk::gemm_phase(lds, 512, 512, 2048, S, E);
    } break;
    case 14: {
        mk::SchedGrid S; S.A = (const char*)p.MIX(); S.Bt = (const char*)p.WfT(); S.nM = T / 256; S.nN = 4; S.lda = D; S.ldb = D;
        EpiResid<false> E; E.basef = nullptr; E.X = p.ACT();
        mk::gemm_phase(lds, D, D, D, S, E);
    } break;
    case 15: moe_router(p, 1, lds, tid, gw, nw); break;
    default: break;
    }
}

constexpr int LDS_BYTES = 163840;
#if !MK_ONE_LAUNCH
__global__ void __launch_bounds__(512, 2) k_phase(Params p, int ph) {
    extern __shared__ __attribute__((aligned(16))) unsigned char shm[];
    run_phase(p, ph, (float*)shm, (MK_LAS unsigned char*)shm);
}
#else
__global__ void __launch_bounds__(512, 2) k_mega(Params p) {
    extern __shared__ __attribute__((aligned(16))) unsigned char shm[];
    float* sm = (float*)shm; MK_LAS unsigned char* lds = (MK_LAS unsigned char*)shm;
    cg::grid_group grid = cg::this_grid();
    volatile MK_LAS unsigned* st = (volatile MK_LAS unsigned*)(lds + LDS_BYTES - 16);
    if (threadIdx.x == 0) { st[0] = 0u; st[1] = 0u; }
    __syncthreads();
    const XcdBarrier xbar = xcd_barrier_post(p.bar(), st);
#ifdef ONLY_PH
    run_phase(p, ONLY_PH, sm, lds); grid.sync(); xcd_barrier(xbar); return;
#endif
    if (gridDim.x == 0x7fffffffu) grid.sync();
    run_phase(p, 0, sm, lds); xcd_barrier(xbar); if (REP_MASK & 1u) { run_phase(p, 0, sm, lds); xcd_barrier(xbar); }
#define PH(n) run_phase(p, n, sm, lds); xcd_barrier(xbar); if (REP_MASK & (1u << n)) { run_phase(p, n, sm, lds); xcd_barrier(xbar); }
    PH(1) PH(3) PH(5) PH(6) PH(7) PH(8) PH(9) PH(10) PH(11) PH(12) PH(13) PH(14) PH(15) PH(16)
    run_phase(p, 17, sm, lds);
#undef PH
}
#endif

extern "C" void kernel_launch(void* const* d_in, const int* in_sizes, int n_in, void* d_out, int out_size, void* d_ws, size_t ws_size, hipStream_t stream) {
    Params p{};
    const float* const* in = (const float* const*)d_in;
    p.x = in[0]; p.norm_mix = in[1]; p.norm_ffn = in[2]; p.w_in = in[3]; p.q_norm = in[4]; p.k_norm = in[5];
    p.lq1 = in[6]; p.lk1 = in[7]; p.lq2 = in[8]; p.lk2 = in[9]; p.subln = in[10]; p.conv_w = in[11]; p.conv_b = in[12];
    p.dt_bias = in[13]; p.a_log = in[14]; p.d_skip = in[15]; p.ssd_norm = in[16]; p.w_out = in[17]; p.w_f = in[18];
    p.rg_w = in[19]; p.rg_b = in[20]; p.re_w = in[21]; p.re_b = in[22]; p.w1 = in[23]; p.w3 = in[24]; p.w2 = in[25];
    p.out = (float*)d_out;
    p.ws = (unsigned char*)d_ws;
    if (ws_size < WS_END) { fprintf(stderr, "workspace too small: %zu < %zu\n", ws_size, (size_t)WS_END); return; }
#if MK_ONE_LAUNCH
    static int grid_blocks = 0;
    if (!grid_blocks) {
        int dev = 0, cus = 0, per_cu = 0;
        (void)hipGetDevice(&dev);
        (void)hipDeviceGetAttribute(&cus, hipDeviceAttributeMultiprocessorCount, dev);
        (void)hipFuncSetAttribute((const void*)k_mega, hipFuncAttributeMaxDynamicSharedMemorySize, LDS_BYTES);
        (void)hipOccupancyMaxActiveBlocksPerMultiprocessor(&per_cu, k_mega, 512, LDS_BYTES);
        if (per_cu > 1) per_cu = 1;
        grid_blocks = cus * per_cu;
    }
    (void)hipMemsetAsync((unsigned char*)d_ws + OFF_bar, 0, (size_t)XCD_BAR_WORDS * 4, stream);
    void* args[] = {&p};
    hipError_t e = hipLaunchCooperativeKernel((void*)k_mega, dim3(grid_blocks), dim3(512), args, LDS_BYTES, stream);
    if (e != hipSuccess) fprintf(stderr, "cooperative launch failed: %s (grid %d)\n", hipGetErrorString(e), grid_blocks);
#else
    (void)hipFuncSetAttribute((const void*)k_phase, hipFuncAttributeMaxDynamicSharedMemorySize, LDS_BYTES);
    for (int ph = 0; ph < NPHASE; ++ph) k_phase<<<256, 512, LDS_BYTES, stream>>>(p, ph);
#endif
}
```
